# Optimizing an MI355X kernel written in HIP

```python
import math
import jax, jax.numpy as jnp
from jax import lax
import numpy as np

D_MODEL = 2048
BATCH = 4
SEQ = 2048
DEPTH = 2

CHUNK = 64
EPS = 1e-6
NEG_INF = -1e30

S5_WIDTH = D_MODEL // 4
S5_GROUP = 16
S5_GROUPS = S5_WIDTH // S5_GROUP
S5_STATE = 64

SSD_WIDTH = D_MODEL // 2
SSD_HEAD_DIM = 64
SSD_HEADS = SSD_WIDTH // SSD_HEAD_DIM
SSD_STATE = 128
SSD_GROUPS = 4
SSD_CONV = 4
SSD_CONV_DIM = SSD_WIDTH + 2 * SSD_GROUPS * SSD_STATE

ATT_WIDTH = D_MODEL // 4
ATT_HEAD_DIM = 64
ATT_HEADS = ATT_WIDTH // ATT_HEAD_DIM
IDX_HEADS = 8
IDX_DIM = 64
TOPK = 256
Q_BLOCK = 128
N_BUCKETS = 32
MAX_DISTANCE = 128
ATT_SCALE = ATT_HEAD_DIM ** -0.5
IDX_W_SCALE = (IDX_HEADS * IDX_DIM) ** -0.5

D_MIX = S5_WIDTH + SSD_WIDTH + ATT_WIDTH
IN_SPLITS = (S5_WIDTH, S5_WIDTH,
             SSD_WIDTH, SSD_CONV_DIM, SSD_HEADS,
             ATT_WIDTH, ATT_HEAD_DIM, ATT_HEAD_DIM,
             IDX_HEADS * IDX_DIM, IDX_DIM, IDX_HEADS,
             ATT_WIDTH)
D_IN = sum(IN_SPLITS)

kernel_name = 'hybrid_s5_ssd_dsa_parallel_heads'


def rmsnorm(x, w):
    xf = x.astype(jnp.float32)
    y = xf * lax.rsqrt(jnp.mean(xf * xf, axis=-1, keepdims=True) + EPS)
    return (y * w.astype(jnp.float32)).astype(x.dtype)


def s5_combine(e1, e2):
    a1r, a1i, b1r, b1i = e1
    a2r, a2i, b2r, b2i = e2
    ar = a2r * a1r - a2i * a1i
    ai = a2r * a1i + a2i * a1r
    br = a2r * b1r - a2i * b1i + b2r
    bi = a2r * b1i + a2i * b1r + b2i
    return ar, ai, br, bi


def s5_mixer(u, A_re, A_im, log_dt, B_re, B_im, C_re, C_im, D, glu_w, glu_b):
    b, L, _ = u.shape
    ug = u.reshape(b, L, S5_GROUPS, S5_GROUP)
    dt = jnp.exp(log_dt)[:, None]
    lre = jnp.minimum(A_re, -1e-4)
    lim = A_im
    mag = jnp.exp(lre * dt)
    lbr = mag * jnp.cos(lim * dt)
    lbi = mag * jnp.sin(lim * dt)
    nr, ni = lbr - 1.0, lbi
    den = lre * lre + lim * lim
    fr = (nr * lre + ni * lim) / den
    fi = (ni * lre - nr * lim) / den
    bbr = fr[..., None] * B_re - fi[..., None] * B_im
    bbi = fr[..., None] * B_im + fi[..., None] * B_re
    bu_r = jnp.einsum('blgc,gpc->blgp', ug, bbr)
    bu_i = jnp.einsum('blgc,gpc->blgp', ug, bbi)
    a_r = jnp.broadcast_to(lbr[None, None], bu_r.shape)
    a_i = jnp.broadcast_to(lbi[None, None], bu_i.shape)
    _, _, xr, xi = lax.associative_scan(s5_combine, (a_r, a_i, bu_r, bu_i), axis=1)
    y = (jnp.einsum('blgp,gcp->blgc', xr, C_re) - jnp.einsum('blgp,gcp->blgc', xi, C_im)
         + D * ug)
    y = jax.nn.gelu(y.reshape(b, L, S5_WIDTH))
    return y * jax.nn.sigmoid(jnp.einsum('ble,ef->blf', y, glu_w) + glu_b)


def causal_depthwise_conv(x, w, bias):
    k = w.shape[0]
    out = lax.conv_general_dilated(x, w[:, None, :], window_strides=(1,), padding=[(k - 1, 0)],
                                   dimension_numbers=('NWC', 'WIO', 'NWC'),
                                   feature_group_count=x.shape[-1])
    return out + bias


def segsum(a):
    t = a.shape[-1]
    ar = jnp.broadcast_to(a[..., :, None], a.shape + (t,))
    strict = jnp.tril(jnp.ones((t, t), dtype=bool), -1)
    ss = jnp.cumsum(jnp.where(strict, ar, 0), axis=-2)
    return jnp.where(jnp.tril(jnp.ones((t, t), dtype=bool)), ss, -jnp.inf)


def ssd_chunked(xd, a, Bm, Cm):
    b, L, h, p = xd.shape
    n = Bm.shape[-1]
    nc = L // CHUNK
    xc = xd.reshape(b, nc, CHUNK, h, p)
    Bc = Bm.reshape(b, nc, CHUNK, h, n)
    Cc = Cm.reshape(b, nc, CHUNK, h, n)
    ac = jnp.moveaxis(a.reshape(b, nc, CHUNK, h), 3, 1)
    a_cs = jnp.cumsum(ac, axis=-1)
    scores = jnp.einsum('bclhn,bcshn->bhcls', Cc, Bc) * jnp.exp(segsum(ac))
    y_diag = jnp.einsum('bhcls,bcshp->bclhp', scores, xc)
    decay_to_end = jnp.exp(a_cs[..., -1:] - a_cs)
    chunk_states = jnp.einsum('bclhn,bhcl,bclhp->bchpn', Bc, decay_to_end, xc)
    chunk_decay = jnp.exp(a_cs[..., -1])

    def carry_state(state, inp):
        st, dec = inp
        return (state * dec[..., None, None] + st).astype(state.dtype), state

    init = jnp.zeros((b, h, p, n), xd.dtype)
    _, prev = lax.scan(carry_state, init,
                       (jnp.moveaxis(chunk_states, 1, 0), jnp.moveaxis(chunk_decay, 2, 0)))
    prev = jnp.moveaxis(prev, 0, 1)
    y_off = jnp.einsum('bclhn,bchpn,bhcl->bclhp', Cc, prev, jnp.exp(a_cs))
    return (y_diag + y_off).reshape(b, L, h, p)


def ssd_mixer(z, xbc, dt_raw, conv_w, conv_b, dt_bias, A_log, D, norm_w):
    b, L, _ = z.shape
    xbc = jax.nn.silu(causal_depthwise_conv(xbc, conv_w, conv_b))
    xs, Bm, Cm = jnp.split(xbc, [SSD_WIDTH, SSD_WIDTH + SSD_GROUPS * SSD_STATE], axis=-1)
    xs = xs.reshape(b, L, SSD_HEADS, SSD_HEAD_DIM)
    rep = SSD_HEADS // SSD_GROUPS
    Bm = jnp.repeat(Bm.reshape(b, L, SSD_GROUPS, SSD_STATE), rep, axis=2)
    Cm = jnp.repeat(Cm.reshape(b, L, SSD_GROUPS, SSD_STATE), rep, axis=2)
    dt = jax.nn.softplus(dt_raw + dt_bias)
    a = dt * (-jnp.exp(A_log))
    y = ssd_chunked(xs * dt[..., None], a, Bm, Cm) + xs * D[:, None]
    y = y.reshape(b, L, SSD_WIDTH)
    return rmsnorm(y * jax.nn.silu(z), norm_w)


def t5_bucket(rel):
    nb = N_BUCKETS // 2
    max_exact = nb // 2
    ret = jnp.where(rel > 0, nb, 0)
    n = jnp.abs(rel)
    nf = jnp.maximum(n, 1).astype(jnp.float32)
    large = max_exact + (jnp.log(nf / max_exact) / math.log(MAX_DISTANCE / max_exact)
                         * (nb - max_exact)).astype(jnp.int32)
    large = jnp.minimum(large, nb - 1)
    return ret + jnp.where(n < max_exact, n, large)


def gather_rows(src, idx):
    return jax.vmap(lambda s, i: s[i])(src, idx)


def dsa_attention(q, k, v, qi, ki, wi, rel_bias):
    b, L, h, dh = q.shape
    n_sel = min(TOPK, L // 4)
    nblk = L // Q_BLOCK
    key_chunk = jnp.arange(L) // CHUNK

    def to_blocks(arr):
        return jnp.moveaxis(arr.reshape((b, nblk, Q_BLOCK) + arr.shape[2:]), 1, 0)

    def one_block(args):
        qb, qib, wb, blk = args
        t = blk * Q_BLOCK + jnp.arange(Q_BLOCK)
        qc = t // CHUNK
        idx_logits = jnp.einsum('bqhd,bsd->bqhs', qib, ki).astype(jnp.float32)
        score = jnp.einsum('bqhs,bqh->bqs', jax.nn.relu(idx_logits), wb.astype(jnp.float32))
        admissible = key_chunk[None, :] <= qc[:, None]
        score = jnp.where(admissible[None], score, NEG_INF)
        _, sel = lax.top_k(score, n_sel)
        valid = (sel // CHUNK) <= qc[None, :, None]
        k_sel = gather_rows(k, sel)
        v_sel = gather_rows(v, sel)
        logits = jnp.einsum('bqhd,bqkd->bqhk', qb, k_sel).astype(jnp.float32) * ATT_SCALE
        bias = rel_bias[t5_bucket(sel - t[None, :, None])]
        logits = logits + jnp.moveaxis(bias, -1, 2).astype(jnp.float32)
        logits = jnp.where(valid[:, :, None, :], logits, NEG_INF)
        p = jax.nn.softmax(logits, axis=-1).astype(v.dtype)
        return jnp.einsum('bqhk,bqkd->bqhd', p, v_sel)

    out = lax.map(one_block, (to_blocks(q), to_blocks(qi), to_blocks(wi * IDX_W_SCALE),
                              jnp.arange(nblk)))
    return jnp.moveaxis(out, 0, 1).reshape(b, L, h * dh)


def setup_inputs(seed: int = 0) -> dict:
    key = jax.random.key(seed)
    ks = jax.random.split(key, 24)
    f32 = jnp.float32

    def nrm(k, shape, s):
        return s * jax.random.normal(k, shape, f32)

    x = jax.random.normal(ks[0], (BATCH, SEQ, D_MODEL), f32)
    norm_w = 1.0 + nrm(ks[1], (DEPTH, D_MODEL), 0.02)
    w_in = nrm(ks[2], (DEPTH, D_MODEL, D_IN), D_MODEL ** -0.5)
    n_idx = jnp.arange(S5_STATE, dtype=f32)
    s5_A_re = -0.5 + nrm(ks[3], (DEPTH, S5_GROUPS, S5_STATE), 0.01)
    s5_A_im = math.pi * n_idx + nrm(ks[4], (DEPTH, S5_GROUPS, S5_STATE), 0.01)
    s5_log_dt = jax.random.uniform(ks[5], (DEPTH, S5_GROUPS), f32, math.log(1e-3), math.log(1e-1))
    s5_B_re = nrm(ks[6], (DEPTH, S5_GROUPS, S5_STATE, S5_GROUP), (2 * S5_GROUP) ** -0.5)
    s5_B_im = nrm(ks[7], (DEPTH, S5_GROUPS, S5_STATE, S5_GROUP), (2 * S5_GROUP) ** -0.5)
    s5_C_re = nrm(ks[8], (DEPTH, S5_GROUPS, S5_GROUP, S5_STATE), S5_STATE ** -0.5)
    s5_C_im = nrm(ks[9], (DEPTH, S5_GROUPS, S5_GROUP, S5_STATE), S5_STATE ** -0.5)
    s5_D = nrm(ks[10], (DEPTH, S5_GROUPS, S5_GROUP), 0.5)
    s5_glu_w = nrm(ks[11], (DEPTH, S5_WIDTH, S5_WIDTH), S5_WIDTH ** -0.5)
    s5_glu_b = nrm(ks[12], (DEPTH, S5_WIDTH), 0.01)
    ssd_conv_w = nrm(ks[13], (DEPTH, SSD_CONV, SSD_CONV_DIM), SSD_CONV ** -0.5)
    ssd_conv_b = nrm(ks[14], (DEPTH, SSD_CONV_DIM), 0.01)
    dt0 = jnp.exp(jax.random.uniform(ks[15], (DEPTH, SSD_HEADS), f32, math.log(1e-3), math.log(1e-1)))
    ssd_dt_bias = dt0 + jnp.log(-jnp.expm1(-dt0))
    ssd_A_log = jnp.log(jax.random.uniform(ks[16], (DEPTH, SSD_HEADS), f32, 1.0, 16.0))
    ssd_D = 1.0 + nrm(ks[17], (DEPTH, SSD_HEADS), 0.1)
    ssd_norm_w = 1.0 + nrm(ks[18], (DEPTH, SSD_WIDTH), 0.02)
    rel_bias = nrm(ks[19], (N_BUCKETS, ATT_HEADS), 0.5)
    w_out = nrm(ks[20], (DEPTH, D_MIX, D_MODEL), D_MIX ** -0.5)
    final_norm_w = 1.0 + nrm(ks[21], (D_MODEL,), 0.02)
    return {'x': x, 'norm_w': norm_w, 'w_in': w_in,
            's5_A_re': s5_A_re, 's5_A_im': s5_A_im, 's5_log_dt': s5_log_dt,
            's5_B_re': s5_B_re, 's5_B_im': s5_B_im, 's5_C_re': s5_C_re, 's5_C_im': s5_C_im,
            's5_D': s5_D, 's5_glu_w': s5_glu_w, 's5_glu_b': s5_glu_b,
            'ssd_conv_w': ssd_conv_w, 'ssd_conv_b': ssd_conv_b, 'ssd_dt_bias': ssd_dt_bias,
            'ssd_A_log': ssd_A_log, 'ssd_D': ssd_D, 'ssd_norm_w': ssd_norm_w,
            'rel_bias': rel_bias, 'w_out': w_out, 'final_norm_w': final_norm_w}


def reference(x, norm_w, w_in, s5_A_re, s5_A_im, s5_log_dt, s5_B_re, s5_B_im, s5_C_re, s5_C_im,
              s5_D, s5_glu_w, s5_glu_b, ssd_conv_w, ssd_conv_b, ssd_dt_bias, ssd_A_log, ssd_D,
              ssd_norm_w, rel_bias, w_out, final_norm_w):
    b, L, _ = x.shape
    offsets = [int(o) for o in np.cumsum(IN_SPLITS)[:-1]]
    for l in range(DEPTH):
        h = rmsnorm(x, norm_w[l])
        proj = jnp.einsum('bld,de->ble', h, w_in[l])
        (s5_u, s5_z, ssd_z, ssd_xbc, ssd_dt, att_q, att_k, att_v,
         idx_q, idx_k, idx_w, att_z) = jnp.split(proj, offsets, axis=-1)
        y_s5 = s5_mixer(s5_u, s5_A_re[l], s5_A_im[l], s5_log_dt[l], s5_B_re[l], s5_B_im[l],
                        s5_C_re[l], s5_C_im[l], s5_D[l], s5_glu_w[l], s5_glu_b[l]) * jax.nn.silu(s5_z)
        y_ssd = ssd_mixer(ssd_z, ssd_xbc, ssd_dt, ssd_conv_w[l], ssd_conv_b[l], ssd_dt_bias[l],
                          ssd_A_log[l], ssd_D[l], ssd_norm_w[l])
        y_att = dsa_attention(att_q.reshape(b, L, ATT_HEADS, ATT_HEAD_DIM), att_k, att_v,
                              idx_q.reshape(b, L, IDX_HEADS, IDX_DIM), idx_k, idx_w,
                              rel_bias) * jax.nn.silu(att_z)
        mix = jnp.concatenate([y_s5, y_ssd, y_att], axis=-1)
        x = x + jnp.einsum('ble,ed->bld', mix, w_out[l])
    return rmsnorm(x, final_norm_w)
```

```cpp
#include <hip/hip_runtime.h>
#include <cstdint>
#include <cstdio>

constexpr int D_MODEL = 2048, BATCH = 4, SEQ = 2048, DEPTH = 2;
constexpr int M_TOK = BATCH * SEQ;
constexpr int D_IN = 5848;
constexpr float EPS = 1e-6f;
constexpr int C_S5U = 0, C_S5Z = 512, C_SSDZ = 1024, C_XBC = 2048, C_DT = 4096, C_AQ = 4112, C_AK = 4624, C_AV = 4688,
              C_IQ = 4752, C_IK = 5264, C_IW = 5328, C_AZ = 5336;
constexpr int MX_S5 = 0, MX_SSD = 512, MX_ATT = 1536;

constexpr size_t MiB = 1u << 20;
constexpr size_t WS_PROJ = 0;
constexpr size_t WS_HX = 184 * MiB;
constexpr size_t WS_MIX = 248 * MiB;
constexpr size_t WS_GLU = 312 * MiB;
constexpr size_t WS_S5P = 328 * MiB;
constexpr size_t WS_END = 330 * MiB;

struct Args {
    const float* in[22];
    float* out;
    unsigned char* ws;
};

__device__ __forceinline__ float wave_sum(float v) {
#pragma unroll
    for (int o = 1; o < 64; o <<= 1) v += __shfl_xor(v, o);
    return v;
}
__device__ __forceinline__ float wave_max(float v) {
#pragma unroll
    for (int o = 1; o < 64; o <<= 1) v = fmaxf(v, __shfl_xor(v, o));
    return v;
}
__device__ __forceinline__ float siluf(float x) { return x / (1.0f + expf(-x)); }
__device__ __forceinline__ float sigmoidf_(float x) { return 1.0f / (1.0f + expf(-x)); }
__device__ __forceinline__ float gelu_tanh(float x) { return 0.5f * x * (1.0f + tanhf(0.7978845608028654f * (x + 0.044715f * x * x * x))); }
__device__ __forceinline__ float softplusf_(float x) { return fmaxf(x, 0.f) + log1pf(expf(-fabsf(x))); }

__device__ __forceinline__ void phase_s5_params(const Args& a) {
    float* lam = (float*)(a.ws + WS_S5P);
    float* bbre = lam + 2 * 32 * 64 * 2;
    float* bbim = bbre + 2 * 32 * 64 * 16;
    const int gt = blockIdx.x * blockDim.x + threadIdx.x;
    if (gt >= 2 * 32 * 64) return;
    const int l = gt / 2048, g = (gt / 64) % 32;
    const float A_re = a.in[3][gt], A_im = a.in[4][gt];
    const float dt = expf(a.in[5][l * 32 + g]);
    const float lre = fminf(A_re, -1e-4f), lim = A_im;
    const float mag = expf(lre * dt);
    const float lbr = mag * cosf(lim * dt), lbi = mag * sinf(lim * dt);
    const float nr = lbr - 1.0f, ni = lbi;
    const float den = lre * lre + lim * lim;
    const float fr = (nr * lre + ni * lim) / den, fi = (ni * lre - nr * lim) / den;
    lam[gt * 2] = lbr; lam[gt * 2 + 1] = lbi;
    for (int c = 0; c < 16; ++c) {
        const float Bre = a.in[6][gt * 16 + c], Bim = a.in[7][gt * 16 + c];
        bbre[gt * 16 + c] = fr * Bre - fi * Bim;
        bbim[gt * 16 + c] = fr * Bim + fi * Bre;
    }
}

__device__ __forceinline__ void phase_rmsnorm(const float* X, const float* w, float* H) {
    const int wave = threadIdx.x >> 6, lane = threadIdx.x & 63;
    const int nw = blockDim.x >> 6;
    for (int row = blockIdx.x * nw + wave; row < M_TOK; row += gridDim.x * nw) {
        const float4* xr = (const float4*)(X + (size_t)row * D_MODEL);
        float4 v[8]; float s = 0.f;
#pragma unroll
        for (int j = 0; j < 8; ++j) { v[j] = xr[lane + 64 * j]; s += v[j].x * v[j].x + v[j].y * v[j].y + v[j].z * v[j].z + v[j].w * v[j].w; }
        s = wave_sum(s);
        const float rs = 1.0f / sqrtf(s * (1.0f / D_MODEL) + EPS);
        float4* hr = (float4*)(H + (size_t)row * D_MODEL);
#pragma unroll
        for (int j = 0; j < 8; ++j) { const float4 ww = ((const float4*)w)[lane + 64 * j];
            float4 o; o.x = v[j].x * rs * ww.x; o.y = v[j].y * rs * ww.y; o.z = v[j].z * rs * ww.z; o.w = v[j].w * rs * ww.w; hr[lane + 64 * j] = o; }
    }
}

__device__ __forceinline__ void gemm_f32(const float* A, int lda, const float* B, int ldb, float* C, int ldc, const float* R, int ldr, int M, int N, int K, float* smem) {
    float* As = smem;
    float* Bs = smem + 16 * 132;
    const int tid = threadIdx.x, ty = tid >> 4, tx = tid & 15;
    const int tilesN = (N + 127) / 128, tilesM = M / 128;
    for (int tile = blockIdx.x; tile < tilesM * tilesN; tile += gridDim.x) {
        const int tm = tile / tilesN, tn = tile % tilesN;
        const int m0 = tm * 128, n0 = tn * 128;
        float acc[4][8];
#pragma unroll
        for (int i = 0; i < 4; ++i)
#pragma unroll
            for (int j = 0; j < 8; ++j) acc[i][j] = 0.f;
        const int bn = n0 + (tid & 31) * 4;
        for (int k0 = 0; k0 < K; k0 += 16) {
            const float4 av = *(const float4*)(A + (size_t)(m0 + (tid >> 2)) * lda + k0 + (tid & 3) * 4);
            float4 bv = make_float4(0.f, 0.f, 0.f, 0.f);
            if (bn < N) bv = *(const float4*)(B + (size_t)(k0 + (tid >> 5)) * ldb + bn);
            __syncthreads();
            As[((tid & 3) * 4 + 0) * 132 + (tid >> 2)] = av.x;
            As[((tid & 3) * 4 + 1) * 132 + (tid >> 2)] = av.y;
            As[((tid & 3) * 4 + 2) * 132 + (tid >> 2)] = av.z;
            As[((tid & 3) * 4 + 3) * 132 + (tid >> 2)] = av.w;
            *(float4*)(Bs + (tid >> 5) * 128 + (tid & 31) * 4) = bv;
            __syncthreads();
#pragma unroll
            for (int k = 0; k < 16; ++k) {
                const float4 a4 = *(const float4*)(As + k * 132 + ty * 4);
                const float4 b0 = *(const float4*)(Bs + k * 128 + tx * 8);
                const float4 b1 = *(const float4*)(Bs + k * 128 + tx * 8 + 4);
                const float aa[4] = {a4.x, a4.y, a4.z, a4.w};
                const float bb[8] = {b0.x, b0.y, b0.z, b0.w, b1.x, b1.y, b1.z, b1.w};
#pragma unroll
                for (int i = 0; i < 4; ++i)
#pragma unroll
                    for (int j = 0; j < 8; ++j) acc[i][j] = fmaf(aa[i], bb[j], acc[i][j]);
            }
        }
#pragma unroll
        for (int i = 0; i < 4; ++i) {
            const int row = m0 + ty * 4 + i;
#pragma unroll
            for (int j = 0; j < 8; ++j) {
                const int col = n0 + tx * 8 + j;
                if (col < N) {
                    float v = acc[i][j];
                    if (R) v += R[(size_t)row * ldr + col];
                    C[(size_t)row * ldc + col] = v;
                }
            }
        }
        __syncthreads();
    }
}

__device__ __forceinline__ void phase_s5(const Args& a, int l) {
    const float* proj = (const float*)(a.ws + WS_PROJ);
    float* mix = (float*)(a.ws + WS_MIX);
    const float* lam = (const float*)(a.ws + WS_S5P) + (size_t)l * 32 * 64 * 2;
    const float* bbre = (const float*)(a.ws + WS_S5P) + 2 * 32 * 64 * 2 + (size_t)l * 32 * 64 * 16;
    const float* bbim = (const float*)(a.ws + WS_S5P) + 2 * 32 * 64 * 2 + 2 * 32 * 64 * 16 + (size_t)l * 32 * 64 * 16;
    const float* Cre = a.in[8] + (size_t)l * 32 * 16 * 64;
    const float* Cim = a.in[9] + (size_t)l * 32 * 16 * 64;
    const float* Dp = a.in[10] + (size_t)l * 512;
    const int wave = threadIdx.x >> 6, lane = threadIdx.x & 63, nw = blockDim.x >> 6;
    for (int unit = blockIdx.x * nw + wave; unit < BATCH * 32; unit += gridDim.x * nw) {
        const int b = unit / 32, g = unit % 32, p = lane;
        const float ar = lam[(g * 64 + p) * 2], ai = lam[(g * 64 + p) * 2 + 1];
        float br[16], bi[16], cr[16], ci[16];
#pragma unroll
        for (int c = 0; c < 16; ++c) { br[c] = bbre[(g * 64 + p) * 16 + c]; bi[c] = bbim[(g * 64 + p) * 16 + c];
            cr[c] = Cre[(g * 16 + c) * 64 + p]; ci[c] = Cim[(g * 16 + c) * 64 + p]; }
        const float dd = Dp[g * 16 + (lane & 15)];
        float xr = 0.f, xi = 0.f;
        for (int t = 0; t < SEQ; ++t) {
            const size_t row = (size_t)b * SEQ + t;
            const float4* up = (const float4*)(proj + row * D_IN + C_S5U + g * 16);
            const float4 u0 = up[0], u1 = up[1], u2 = up[2], u3 = up[3];
            const float u[16] = {u0.x, u0.y, u0.z, u0.w, u1.x, u1.y, u1.z, u1.w, u2.x, u2.y, u2.z, u2.w, u3.x, u3.y, u3.z, u3.w};
            float bur = 0.f, bui = 0.f;
#pragma unroll
            for (int c = 0; c < 16; ++c) { bur = fmaf(br[c], u[c], bur); bui = fmaf(bi[c], u[c], bui); }
            const float nxr = ar * xr - ai * xi + bur;
            const float nxi = ar * xi + ai * xr + bui;
            xr = nxr; xi = nxi;
            float myy = 0.f;
#pragma unroll
            for (int c = 0; c < 16; ++c) { float v = xr * cr[c] - xi * ci[c]; v = wave_sum(v); if ((lane & 15) == c) myy = v; }
            if (lane < 16) {
                const float ul = proj[row * D_IN + C_S5U + g * 16 + lane];
                const float y = myy + dd * ul;
                mix[row * D_MODEL + MX_S5 + g * 16 + lane] = gelu_tanh(y);
            }
        }
    }
}

__device__ __forceinline__ void phase_glu_ew(const Args& a, int l) {
    const float* proj = (const float*)(a.ws + WS_PROJ);
    float* mix = (float*)(a.ws + WS_MIX);
    const float* tmp = (const float*)(a.ws + WS_GLU);
    const float* gb = a.in[12] + (size_t)l * 512;
    for (size_t i = (size_t)blockIdx.x * blockDim.x + threadIdx.x; i < (size_t)M_TOK * 512; i += (size_t)gridDim.x * blockDim.x) {
        const size_t row = i / 512; const int c = (int)(i % 512);
        const float yg = mix[row * D_MODEL + MX_S5 + c];
        const float z = proj[row * D_IN + C_S5Z + c];
        mix[row * D_MODEL + MX_S5 + c] = yg * sigmoidf_(tmp[i] + gb[c]) * siluf(z);
    }
}

__device__ __forceinline__ void phase_conv(const Args& a, int l) {
    const float* proj = (const float*)(a.ws + WS_PROJ);
    float* xc = (float*)(a.ws + WS_HX);
    const float* cw = a.in[13] + (size_t)l * 4 * 2048;
    const float* cb = a.in[14] + (size_t)l * 2048;
    for (size_t i = (size_t)blockIdx.x * blockDim.x + threadIdx.x; i < (size_t)M_TOK * 2048; i += (size_t)gridDim.x * blockDim.x) {
        const size_t row = i / 2048; const int ch = (int)(i % 2048);
        const int t = (int)(row % SEQ);
        float acc = cb[ch];
#pragma unroll
        for (int k = 0; k < 4; ++k) { const int tt = t - 3 + k; if (tt >= 0) acc = fmaf(cw[k * 2048 + ch], proj[(row - 3 + k) * D_IN + C_XBC + ch], acc); }
        xc[i] = siluf(acc);
    }
}

__device__ __forceinline__ void phase_ssd_scan(const Args& a, int l) {
    const float* proj = (const float*)(a.ws + WS_PROJ);
    const float* xc = (const float*)(a.ws + WS_HX);
    float* mix = (float*)(a.ws + WS_MIX);
    const int tid = threadIdx.x, p = tid >> 3, nq = tid & 7;
    for (int unit = blockIdx.x; unit < BATCH * 16; unit += gridDim.x) {
        const int b = unit / 16, h = unit % 16, g = h / 4;
        const float dtb = a.in[15][l * 16 + h], Aneg = -expf(a.in[16][l * 16 + h]), Dh = a.in[17][l * 16 + h];
        float st[16];
#pragma unroll
        for (int i = 0; i < 16; ++i) st[i] = 0.f;
        for (int t = 0; t < SEQ; ++t) {
            const size_t row = (size_t)b * SEQ + t;
            const float dt = softplusf_(proj[row * D_IN + C_DT + h] + dtb);
            const float dec = expf(dt * Aneg);
            const float xv = xc[row * 2048 + h * 64 + p];
            const float xd = xv * dt;
            const float4* Bp = (const float4*)(xc + row * 2048 + 1024 + g * 128 + nq * 16);
            const float4* Cp = (const float4*)(xc + row * 2048 + 1536 + g * 128 + nq * 16);
            float acc = 0.f;
#pragma unroll
            for (int q = 0; q < 4; ++q) {
                const float4 Bv = Bp[q], Cv = Cp[q];
                st[q * 4 + 0] = fmaf(st[q * 4 + 0], dec, Bv.x * xd); acc = fmaf(Cv.x, st[q * 4 + 0], acc);
                st[q * 4 + 1] = fmaf(st[q * 4 + 1], dec, Bv.y * xd); acc = fmaf(Cv.y, st[q * 4 + 1], acc);
                st[q * 4 + 2] = fmaf(st[q * 4 + 2], dec, Bv.z * xd); acc = fmaf(Cv.z, st[q * 4 + 2], acc);
                st[q * 4 + 3] = fmaf(st[q * 4 + 3], dec, Bv.w * xd); acc = fmaf(Cv.w, st[q * 4 + 3], acc);
            }
            acc += __shfl_xor(acc, 1); acc += __shfl_xor(acc, 2); acc += __shfl_xor(acc, 4);
            if (nq == 0) mix[row * D_MODEL + MX_SSD + h * 64 + p] = acc + xv * Dh;
        }
    }
}

__device__ __forceinline__ void phase_ssd_norm(const Args& a, int l) {
    const float* proj = (const float*)(a.ws + WS_PROJ);
    float* mix = (float*)(a.ws + WS_MIX);
    const float* nwp = a.in[18] + (size_t)l * 1024;
    const int wave = threadIdx.x >> 6, lane = threadIdx.x & 63, nw = blockDim.x >> 6;
    for (int row = blockIdx.x * nw + wave; row < M_TOK; row += gridDim.x * nw) {
        float4 v[4]; float s = 0.f;
#pragma unroll
        for (int j = 0; j < 4; ++j) {
            const float4 y = *(const float4*)(mix + (size_t)row * D_MODEL + MX_SSD + (lane + 64 * j) * 4);
            const float4 z = *(const float4*)(proj + (size_t)row * D_IN + C_SSDZ + (lane + 64 * j) * 4);
            v[j].x = y.x * siluf(z.x); v[j].y = y.y * siluf(z.y); v[j].z = y.z * siluf(z.z); v[j].w = y.w * siluf(z.w);
            s += v[j].x * v[j].x + v[j].y * v[j].y + v[j].z * v[j].z + v[j].w * v[j].w;
        }
        s = wave_sum(s);
        const float rs = 1.0f / sqrtf(s * (1.0f / 1024.f) + EPS);
#pragma unroll
        for (int j = 0; j < 4; ++j) {
            const float4 ww = *(const float4*)(nwp + (lane + 64 * j) * 4);
            float4 o; o.x = v[j].x * rs * ww.x; o.y = v[j].y * rs * ww.y; o.z = v[j].z * rs * ww.z; o.w = v[j].w * rs * ww.w;
            *(float4*)(mix + (size_t)row * D_MODEL + MX_SSD + (lane + 64 * j) * 4) = o;
        }
    }
}

__device__ __forceinline__ int t5_bucket(int rel) {
    const int ret = rel > 0 ? 16 : 0; const int n = rel < 0 ? -rel : rel;
    if (n < 8) return ret + n;
    const int e = 31 - __clz(n);
    int v = 8 + 2 * (e - 3) + ((n * n) >= (1 << (2 * e + 1)) ? 1 : 0);
    return ret + (v < 15 ? v : 15);
}

__device__ __forceinline__ void phase_dsa(const Args& a, int l, float* smem) {
    const float* proj = (const float*)(a.ws + WS_PROJ);
    float* mix = (float*)(a.ws + WS_MIX);
    const float* relb = a.in[19];
    float* qi = smem;
    float* qa = smem + 512;
    float* wv = smem + 1024;
    float* sc = smem + 1040;
    int* sel = (int*)(smem + 1040 + 2048);
    float* pl = smem + 1040 + 2048 + 256;
    const int tid = threadIdx.x, wave = tid >> 6, lane = tid & 63;
    for (int qidx = blockIdx.x; qidx < M_TOK; qidx += gridDim.x) {
        const int b = qidx / SEQ, t = qidx % SEQ, c = t / 64, nk = 64 * (c + 1);
        const size_t row = (size_t)qidx;
        __syncthreads();
        qi[tid] = proj[row * D_IN + C_IQ + tid];
        qa[tid] = proj[row * D_IN + C_AQ + tid];
        if (tid < 8) wv[tid] = proj[row * D_IN + C_IW + tid] * 0.044194173824159216f;
        __syncthreads();
        for (int key = tid; key < nk; key += 512) {
            const float4* kr = (const float4*)(proj + ((size_t)b * SEQ + key) * D_IN + C_IK);
            float4 kv[16];
#pragma unroll
            for (int j = 0; j < 16; ++j) kv[j] = kr[j];
            float s = 0.f;
            asm volatile("" ::: "memory");
#pragma unroll 1
            for (int h = 0; h < 8; ++h) {
                float d = 0.f;
#pragma unroll
                for (int j = 0; j < 16; ++j) { const float4 q4 = *(const float4*)(qi + h * 64 + j * 4);
                    d = fmaf(q4.x, kv[j].x, d); d = fmaf(q4.y, kv[j].y, d); d = fmaf(q4.z, kv[j].z, d); d = fmaf(q4.w, kv[j].w, d); }
                s += fmaxf(d, 0.f) * wv[h];
            }
            sc[key] = s;
        }
        __syncthreads();
        int nsel;
        if (nk <= 256) { for (int i = tid; i < nk; i += 512) sel[i] = i; nsel = nk; }
        else {
            for (int i = tid; i < nk; i += 512) {
                const float si = sc[i]; int rank = 0;
#pragma unroll 4
                for (int j = 0; j < nk; ++j) { const float sj = sc[j]; rank += (sj > si || (sj == si && j < i)) ? 1 : 0; }
                if (rank < 256) sel[rank] = i;
            }
            nsel = 256;
        }
        __syncthreads();
        {
            const int h = wave;
            float lg[4]; float mx = -3.0e38f;
#pragma unroll
            for (int jj = 0; jj < 4; ++jj) {
                const int j = lane + 64 * jj; lg[jj] = -3.0e38f;
                if (j < nsel) {
                    const int key = sel[j];
                    const float4* kr = (const float4*)(proj + ((size_t)b * SEQ + key) * D_IN + C_AK);
                    float d = 0.f;
#pragma unroll
                    for (int q = 0; q < 16; ++q) { const float4 k4 = kr[q]; const float4 q4 = *(const float4*)(qa + h * 64 + q * 4);
                        d = fmaf(q4.x, k4.x, d); d = fmaf(q4.y, k4.y, d); d = fmaf(q4.z, k4.z, d); d = fmaf(q4.w, k4.w, d); }
                    lg[jj] = d * 0.125f + relb[t5_bucket(key - t) * 8 + h];
                    mx = fmaxf(mx, lg[jj]);
                }
            }
            mx = wave_max(mx);
            float sum = 0.f;
#pragma unroll
            for (int jj = 0; jj < 4; ++jj) { const int j = lane + 64 * jj; if (j < nsel) { const float e = expf(lg[jj] - mx); pl[h * 256 + j] = e; sum += e; } }
            sum = wave_sum(sum);
            __builtin_amdgcn_s_waitcnt(0);
            float o = 0.f;
            for (int j = 0; j < nsel; ++j) { const int key = sel[j]; o = fmaf(pl[h * 256 + j], proj[((size_t)b * SEQ + key) * D_IN + C_AV + lane], o); }
            const float z = proj[row * D_IN + C_AZ + h * 64 + lane];
            mix[row * D_MODEL + MX_ATT + h * 64 + lane] = (o / sum) * siluf(z);
        }
    }
}

enum { PH_S5P = 0, PH_NORM, PH_GEMM1, PH_S5, PH_GLUG, PH_GLUE, PH_CONV, PH_SSDSCAN, PH_SSDNORM, PH_DSA, PH_GEMM2, PH_FINAL };

template <int phase>
__global__ void __launch_bounds__(512) k_phase(Args a, int l) {
    extern __shared__ __attribute__((aligned(16))) float smem[];
    const float* xcur = (l == 0) ? a.in[0] : a.out;
    if constexpr (phase == PH_S5P) phase_s5_params(a);
    if constexpr (phase == PH_NORM) phase_rmsnorm(xcur, a.in[1] + (size_t)l * D_MODEL, (float*)(a.ws + WS_HX));
    if constexpr (phase == PH_GEMM1) gemm_f32((const float*)(a.ws + WS_HX), D_MODEL, a.in[2] + (size_t)l * D_MODEL * D_IN, D_IN, (float*)(a.ws + WS_PROJ), D_IN, nullptr, 0, M_TOK, D_IN, D_MODEL, smem);
    if constexpr (phase == PH_S5) phase_s5(a, l);
    if constexpr (phase == PH_GLUG) gemm_f32((const float*)(a.ws + WS_MIX) + MX_S5, D_MODEL, a.in[11] + (size_t)l * 512 * 512, 512, (float*)(a.ws + WS_GLU), 512, nullptr, 0, M_TOK, 512, 512, smem);
    if constexpr (phase == PH_GLUE) phase_glu_ew(a, l);
    if constexpr (phase == PH_CONV) phase_conv(a, l);
    if constexpr (phase == PH_SSDSCAN) phase_ssd_scan(a, l);
    if constexpr (phase == PH_SSDNORM) phase_ssd_norm(a, l);
    if constexpr (phase == PH_DSA) phase_dsa(a, l, smem);
    if constexpr (phase == PH_GEMM2) gemm_f32((const float*)(a.ws + WS_MIX), D_MODEL, a.in[20] + (size_t)l * D_MODEL * D_MODEL, D_MODEL, a.out, D_MODEL, xcur, D_MODEL, M_TOK, D_MODEL, D_MODEL, smem);
    if constexpr (phase == PH_FINAL) phase_rmsnorm(a.out, a.in[21], a.out);
}

extern "C" void kernel_launch(void* const* d_in, const int* in_sizes, int n_in, void* d_out, int out_size, void* d_ws, size_t ws_size, hipStream_t stream) {
    if (n_in != 22 || out_size != M_TOK * D_MODEL || ws_size < WS_END) {
        fprintf(stderr, "kernel_launch: unexpected problem: n_in %d out %d ws %zu\n", n_in, out_size, ws_size);
        return;
    }
    Args a{};
    for (int i = 0; i < 22; ++i) a.in[i] = (const float*)d_in[i];
    a.out = (float*)d_out; a.ws = (unsigned char*)d_ws;
    const int G = 1024, T = 512; const size_t L = 32768;
    hipLaunchKernelGGL(k_phase<PH_S5P>, dim3(8), dim3(T), L, stream, a, 0);
    for (int l = 0; l < DEPTH; ++l) {
        hipLaunchKernelGGL(k_phase<PH_NORM>, dim3(G), dim3(T), L, stream, a, l);
        hipLaunchKernelGGL(k_phase<PH_GEMM1>, dim3(G), dim3(T), L, stream, a, l);
        hipLaunchKernelGGL(k_phase<PH_S5>, dim3(G), dim3(T), L, stream, a, l);
        hipLaunchKernelGGL(k_phase<PH_GLUG>, dim3(G), dim3(T), L, stream, a, l);
        hipLaunchKernelGGL(k_phase<PH_GLUE>, dim3(G), dim3(T), L, stream, a, l);
        hipLaunchKernelGGL(k_phase<PH_CONV>, dim3(G), dim3(T), L, stream, a, l);
        hipLaunchKernelGGL(k_phase<PH_SSDSCAN>, dim3(G), dim3(T), L, stream, a, l);
        hipLaunchKernelGGL(k_phase<PH_SSDNORM>, dim3(G), dim3(T), L, stream, a, l);
        hipLaunchKernelGGL(k_phase<PH_DSA>, dim3(G), dim3(T), L, stream, a, l);
        hipLaunchKernelGGL(k_phase<PH_GEMM2>, dim3(G), dim3(T), L, stream, a, l);
    }
    hipLaunchKernelGGL(k_phase<PH_FINAL>, dim3(G), dim3(T), L, stream, a, 0);
}
```

```cpp
#include <hip/hip_runtime.h>
#include <cstdint>
#include <cstdio>
#include <hip/hip_cooperative_groups.h>
namespace cg = cooperative_groups;

constexpr int D_MODEL = 2048, BATCH = 4, SEQ = 2048, DEPTH = 2;
constexpr int M_TOK = BATCH * SEQ;
constexpr int D_IN = 5848;
constexpr float EPS = 1e-6f;
constexpr int C_S5U = 0, C_S5Z = 512, C_SSDZ = 1024, C_XBC = 2048, C_DT = 4096, C_AQ = 4112, C_AK = 4624, C_AV = 4688,
              C_IQ = 4752, C_IK = 5264, C_IW = 5328, C_AZ = 5336;
constexpr int MX_S5 = 0, MX_SSD = 512, MX_ATT = 1536;

constexpr size_t MiB = 1u << 20;
constexpr size_t WS_PROJ = 0;
constexpr size_t WS_HX = 184 * MiB;
constexpr size_t WS_MIX = 248 * MiB;
constexpr size_t WS_GLU = 312 * MiB;
constexpr size_t WS_S5P = 328 * MiB;
constexpr size_t WS_END = 330 * MiB;

struct Args {
    const float* in[22];
    float* out;
    unsigned char* ws;
};

__device__ __forceinline__ float wave_sum(float v) {
#pragma unroll
    for (int o = 1; o < 64; o <<= 1) v += __shfl_xor(v, o);
    return v;
}
__device__ __forceinline__ float wave_max(float v) {
#pragma unroll
    for (int o = 1; o < 64; o <<= 1) v = fmaxf(v, __shfl_xor(v, o));
    return v;
}
__device__ __forceinline__ float siluf(float x) { return x / (1.0f + expf(-x)); }
__device__ __forceinline__ float sigmoidf_(float x) { return 1.0f / (1.0f + expf(-x)); }
__device__ __forceinline__ float gelu_tanh(float x) { return 0.5f * x * (1.0f + tanhf(0.7978845608028654f * (x + 0.044715f * x * x * x))); }
__device__ __forceinline__ float softplusf_(float x) { return fmaxf(x, 0.f) + log1pf(expf(-fabsf(x))); }

__device__ __forceinline__ void phase_s5_params(const Args& a) {
    float* lam = (float*)(a.ws + WS_S5P);
    float* bbre = lam + 2 * 32 * 64 * 2;
    float* bbim = bbre + 2 * 32 * 64 * 16;
    const int gt = blockIdx.x * blockDim.x + threadIdx.x;
    if (gt >= 2 * 32 * 64) return;
    const int l = gt / 2048, g = (gt / 64) % 32;
    const float A_re = a.in[3][gt], A_im = a.in[4][gt];
    const float dt = expf(a.in[5][l * 32 + g]);
    const float lre = fminf(A_re, -1e-4f), lim = A_im;
    const float mag = expf(lre * dt);
    const float lbr = mag * cosf(lim * dt), lbi = mag * sinf(lim * dt);
    const float nr = lbr - 1.0f, ni = lbi;
    const float den = lre * lre + lim * lim;
    const float fr = (nr * lre + ni * lim) / den, fi = (ni * lre - nr * lim) / den;
    lam[gt * 2] = lbr; lam[gt * 2 + 1] = lbi;
    for (int c = 0; c < 16; ++c) {
        const float Bre = a.in[6][gt * 16 + c], Bim = a.in[7][gt * 16 + c];
        bbre[gt * 16 + c] = fr * Bre - fi * Bim;
        bbim[gt * 16 + c] = fr * Bim + fi * Bre;
    }
}

__device__ __forceinline__ void phase_rmsnorm(const float* X, const float* w, float* H) {
    const int wave = threadIdx.x >> 6, lane = threadIdx.x & 63;
    const int nw = blockDim.x >> 6;
    for (int row = blockIdx.x * nw + wave; row < M_TOK; row += gridDim.x * nw) {
        const float4* xr = (const float4*)(X + (size_t)row * D_MODEL);
        float4 v[8]; float s = 0.f;
#pragma unroll
        for (int j = 0; j < 8; ++j) { v[j] = xr[lane + 64 * j]; s += v[j].x * v[j].x + v[j].y * v[j].y + v[j].z * v[j].z + v[j].w * v[j].w; }
        s = wave_sum(s);
        const float rs = 1.0f / sqrtf(s * (1.0f / D_MODEL) + EPS);
        float4* hr = (float4*)(H + (size_t)row * D_MODEL);
#pragma unroll
        for (int j = 0; j < 8; ++j) { const float4 ww = ((const float4*)w)[lane + 64 * j];
            float4 o; o.x = v[j].x * rs * ww.x; o.y = v[j].y * rs * ww.y; o.z = v[j].z * rs * ww.z; o.w = v[j].w * rs * ww.w; hr[lane + 64 * j] = o; }
    }
}

__device__ __forceinline__ void gemm_f32(const float* A, int lda, const float* B, int ldb, float* C, int ldc, const float* R, int ldr, int M, int N, int K, float* smem) {
    float* As = smem;
    float* Bs = smem + 16 * 132;
    const int tid = threadIdx.x, ty = tid >> 4, tx = tid & 15;
    const int tilesN = (N + 127) / 128, tilesM = M / 128;
    for (int tile = blockIdx.x; tile < tilesM * tilesN; tile += gridDim.x) {
        const int tm = tile / tilesN, tn = tile % tilesN;
        const int m0 = tm * 128, n0 = tn * 128;
        float acc[4][8];
#pragma unroll
        for (int i = 0; i < 4; ++i)
#pragma unroll
            for (int j = 0; j < 8; ++j) acc[i][j] = 0.f;
        const int bn = n0 + (tid & 31) * 4;
        for (int k0 = 0; k0 < K; k0 += 16) {
            const float4 av = *(const float4*)(A + (size_t)(m0 + (tid >> 2)) * lda + k0 + (tid & 3) * 4);
            float4 bv = make_float4(0.f, 0.f, 0.f, 0.f);
            if (bn < N) bv = *(const float4*)(B + (size_t)(k0 + (tid >> 5)) * ldb + bn);
            __syncthreads();
            As[((tid & 3) * 4 + 0) * 132 + (tid >> 2)] = av.x;
            As[((tid & 3) * 4 + 1) * 132 + (tid >> 2)] = av.y;
            As[((tid & 3) * 4 + 2) * 132 + (tid >> 2)] = av.z;
            As[((tid & 3) * 4 + 3) * 132 + (tid >> 2)] = av.w;
            *(float4*)(Bs + (tid >> 5) * 128 + (tid & 31) * 4) = bv;
            __syncthreads();
#pragma unroll
            for (int k = 0; k < 16; ++k) {
                const float4 a4 = *(const float4*)(As + k * 132 + ty * 4);
                const float4 b0 = *(const float4*)(Bs + k * 128 + tx * 8);
                const float4 b1 = *(const float4*)(Bs + k * 128 + tx * 8 + 4);
                const float aa[4] = {a4.x, a4.y, a4.z, a4.w};
                const float bb[8] = {b0.x, b0.y, b0.z, b0.w, b1.x, b1.y, b1.z, b1.w};
#pragma unroll
                for (int i = 0; i < 4; ++i)
#pragma unroll
                    for (int j = 0; j < 8; ++j) acc[i][j] = fmaf(aa[i], bb[j], acc[i][j]);
            }
        }
#pragma unroll
        for (int i = 0; i < 4; ++i) {
            const int row = m0 + ty * 4 + i;
#pragma unroll
            for (int j = 0; j < 8; ++j) {
                const int col = n0 + tx * 8 + j;
                if (col < N) {
                    float v = acc[i][j];
                    if (R) v += R[(size_t)row * ldr + col];
                    C[(size_t)row * ldc + col] = v;
                }
            }
        }
        __syncthreads();
    }
}

__device__ __forceinline__ void phase_s5(const Args& a, int l) {
    const float* proj = (const float*)(a.ws + WS_PROJ);
    float* mix = (float*)(a.ws + WS_MIX);
    const float* lam = (const float*)(a.ws + WS_S5P) + (size_t)l * 32 * 64 * 2;
    const float* bbre = (const float*)(a.ws + WS_S5P) + 2 * 32 * 64 * 2 + (size_t)l * 32 * 64 * 16;
    const float* bbim = (const float*)(a.ws + WS_S5P) + 2 * 32 * 64 * 2 + 2 * 32 * 64 * 16 + (size_t)l * 32 * 64 * 16;
    const float* Cre = a.in[8] + (size_t)l * 32 * 16 * 64;
    const float* Cim = a.in[9] + (size_t)l * 32 * 16 * 64;
    const float* Dp = a.in[10] + (size_t)l * 512;
    const int wave = threadIdx.x >> 6, lane = threadIdx.x & 63, nw = blockDim.x >> 6;
    for (int unit = blockIdx.x * nw + wave; unit < BATCH * 32; unit += gridDim.x * nw) {
        const int b = unit / 32, g = unit % 32, p = lane;
        const float ar = lam[(g * 64 + p) * 2], ai = lam[(g * 64 + p) * 2 + 1];
        float br[16], bi[16], cr[16], ci[16];
#pragma unroll
        for (int c = 0; c < 16; ++c) { br[c] = bbre[(g * 64 + p) * 16 + c]; bi[c] = bbim[(g * 64 + p) * 16 + c];
            cr[c] = Cre[(g * 16 + c) * 64 + p]; ci[c] = Cim[(g * 16 + c) * 64 + p]; }
        const float dd = Dp[g * 16 + (lane & 15)];
        float xr = 0.f, xi = 0.f;
        for (int t = 0; t < SEQ; ++t) {
            const size_t row = (size_t)b * SEQ + t;
            const float4* up = (const float4*)(proj + row * D_IN + C_S5U + g * 16);
            const float4 u0 = up[0], u1 = up[1], u2 = up[2], u3 = up[3];
            const float u[16] = {u0.x, u0.y, u0.z, u0.w, u1.x, u1.y, u1.z, u1.w, u2.x, u2.y, u2.z, u2.w, u3.x, u3.y, u3.z, u3.w};
            float bur = 0.f, bui = 0.f;
#pragma unroll
            for (int c = 0; c < 16; ++c) { bur = fmaf(br[c], u[c], bur); bui = fmaf(bi[c], u[c], bui); }
            const float nxr = ar * xr - ai * xi + bur;
            const float nxi = ar * xi + ai * xr + bui;
            xr = nxr; xi = nxi;
            float myy = 0.f;
#pragma unroll
            for (int c = 0; c < 16; ++c) { float v = xr * cr[c] - xi * ci[c]; v = wave_sum(v); if ((lane & 15) == c) myy = v; }
            if (lane < 16) {
                const float ul = proj[row * D_IN + C_S5U + g * 16 + lane];
                const float y = myy + dd * ul;
                mix[row * D_MODEL + MX_S5 + g * 16 + lane] = gelu_tanh(y);
            }
        }
    }
}

__device__ __forceinline__ void phase_glu_ew(const Args& a, int l) {
    const float* proj = (const float*)(a.ws + WS_PROJ);
    float* mix = (float*)(a.ws + WS_MIX);
    const float* tmp = (const float*)(a.ws + WS_GLU);
    const float* gb = a.in[12] + (size_t)l * 512;
    for (size_t i = (size_t)blockIdx.x * blockDim.x + threadIdx.x; i < (size_t)M_TOK * 512; i += (size_t)gridDim.x * blockDim.x) {
        const size_t row = i / 512; const int c = (int)(i % 512);
        const float yg = mix[row * D_MODEL + MX_S5 + c];
        const float z = proj[row * D_IN + C_S5Z + c];
        mix[row * D_MODEL + MX_S5 + c] = yg * sigmoidf_(tmp[i] + gb[c]) * siluf(z);
    }
}

__device__ __forceinline__ void phase_conv(const Args& a, int l) {
    const float* proj = (const float*)(a.ws + WS_PROJ);
    float* xc = (float*)(a.ws + WS_HX);
    const float* cw = a.in[13] + (size_t)l * 4 * 2048;
    const float* cb = a.in[14] + (size_t)l * 2048;
    for (size_t i = (size_t)blockIdx.x * blockDim.x + threadIdx.x; i < (size_t)M_TOK * 2048; i += (size_t)gridDim.x * blockDim.x) {
        const size_t row = i / 2048; const int ch = (int)(i % 2048);
        const int t = (int)(row % SEQ);
        float acc = cb[ch];
#pragma unroll
        for (int k = 0; k < 4; ++k) { const int tt = t - 3 + k; if (tt >= 0) acc = fmaf(cw[k * 2048 + ch], proj[(row - 3 + k) * D_IN + C_XBC + ch], acc); }
        xc[i] = siluf(acc);
    }
}

__device__ __forceinline__ void phase_ssd_scan(const Args& a, int l) {
    const float* proj = (const float*)(a.ws + WS_PROJ);
    const float* xc = (const float*)(a.ws + WS_HX);
    float* mix = (float*)(a.ws + WS_MIX);
    const int tid = threadIdx.x, p = tid >> 3, nq = tid & 7;
    for (int unit = blockIdx.x; unit < BATCH * 16; unit += gridDim.x) {
        const int b = unit / 16, h = unit % 16, g = h / 4;
        const float dtb = a.in[15][l * 16 + h], Aneg = -expf(a.in[16][l * 16 + h]), Dh = a.in[17][l * 16 + h];
        float st[16];
#pragma unroll
        for (int i = 0; i < 16; ++i) st[i] = 0.f;
        for (int t = 0; t < SEQ; ++t) {
            const size_t row = (size_t)b * SEQ + t;
            const float dt = softplusf_(proj[row * D_IN + C_DT + h] + dtb);
            const float dec = expf(dt * Aneg);
            const float xv = xc[row * 2048 + h * 64 + p];
            const float xd = xv * dt;
            const float4* Bp = (const float4*)(xc + row * 2048 + 1024 + g * 128 + nq * 16);
            const float4* Cp = (const float4*)(xc + row * 2048 + 1536 + g * 128 + nq * 16);
            float acc = 0.f;
#pragma unroll
            for (int q = 0; q < 4; ++q) {
                const float4 Bv = Bp[q], Cv = Cp[q];
                st[q * 4 + 0] = fmaf(st[q * 4 + 0], dec, Bv.x * xd); acc = fmaf(Cv.x, st[q * 4 + 0], acc);
                st[q * 4 + 1] = fmaf(st[q * 4 + 1], dec, Bv.y * xd); acc = fmaf(Cv.y, st[q * 4 + 1], acc);
                st[q * 4 + 2] = fmaf(st[q * 4 + 2], dec, Bv.z * xd); acc = fmaf(Cv.z, st[q * 4 + 2], acc);
                st[q * 4 + 3] = fmaf(st[q * 4 + 3], dec, Bv.w * xd); acc = fmaf(Cv.w, st[q * 4 + 3], acc);
            }
            acc += __shfl_xor(acc, 1); acc += __shfl_xor(acc, 2); acc += __shfl_xor(acc, 4);
            if (nq == 0) mix[row * D_MODEL + MX_SSD + h * 64 + p] = acc + xv * Dh;
        }
    }
}

__device__ __forceinline__ void phase_ssd_norm(const Args& a, int l) {
    const float* proj = (const float*)(a.ws + WS_PROJ);
    float* mix = (float*)(a.ws + WS_MIX);
    const float* nwp = a.in[18] + (size_t)l * 1024;
    const int wave = threadIdx.x >> 6, lane = threadIdx.x & 63, nw = blockDim.x >> 6;
    for (int row = blockIdx.x * nw + wave; row < M_TOK; row += gridDim.x * nw) {
        float4 v[4]; float s = 0.f;
#pragma unroll
        for (int j = 0; j < 4; ++j) {
            const float4 y = *(const float4*)(mix + (size_t)row * D_MODEL + MX_SSD + (lane + 64 * j) * 4);
            const float4 z = *(const float4*)(proj + (size_t)row * D_IN + C_SSDZ + (lane + 64 * j) * 4);
            v[j].x = y.x * siluf(z.x); v[j].y = y.y * siluf(z.y); v[j].z = y.z * siluf(z.z); v[j].w = y.w * siluf(z.w);
            s += v[j].x * v[j].x + v[j].y * v[j].y + v[j].z * v[j].z + v[j].w * v[j].w;
        }
        s = wave_sum(s);
        const float rs = 1.0f / sqrtf(s * (1.0f / 1024.f) + EPS);
#pragma unroll
        for (int j = 0; j < 4; ++j) {
            const float4 ww = *(const float4*)(nwp + (lane + 64 * j) * 4);
            float4 o; o.x = v[j].x * rs * ww.x; o.y = v[j].y * rs * ww.y; o.z = v[j].z * rs * ww.z; o.w = v[j].w * rs * ww.w;
            *(float4*)(mix + (size_t)row * D_MODEL + MX_SSD + (lane + 64 * j) * 4) = o;
        }
    }
}

__device__ __forceinline__ int t5_bucket(int rel) {
    const int ret = rel > 0 ? 16 : 0; const int n = rel < 0 ? -rel : rel;
    if (n < 8) return ret + n;
    const int e = 31 - __clz(n);
    int v = 8 + 2 * (e - 3) + ((n * n) >= (1 << (2 * e + 1)) ? 1 : 0);
    return ret + (v < 15 ? v : 15);
}

__device__ __forceinline__ void phase_dsa(const Args& a, int l, float* smem) {
    const float* proj = (const float*)(a.ws + WS_PROJ);
    float* mix = (float*)(a.ws + WS_MIX);
    const float* relb = a.in[19];
    float* qi = smem;
    float* qa = smem + 512;
    float* wv = smem + 1024;
    float* sc = smem + 1040;
    int* sel = (int*)(smem + 1040 + 2048);
    float* pl = smem + 1040 + 2048 + 256;
    const int tid = threadIdx.x, wave = tid >> 6, lane = tid & 63;
    for (int qidx = blockIdx.x; qidx < M_TOK; qidx += gridDim.x) {
        const int b = qidx / SEQ, t = qidx % SEQ, c = t / 64, nk = 64 * (c + 1);
        const size_t row = (size_t)qidx;
        __syncthreads();
        qi[tid] = proj[row * D_IN + C_IQ + tid];
        qa[tid] = proj[row * D_IN + C_AQ + tid];
        if (tid < 8) wv[tid] = proj[row * D_IN + C_IW + tid] * 0.044194173824159216f;
        __syncthreads();
        for (int key = tid; key < nk; key += 512) {
            const float4* kr = (const float4*)(proj + ((size_t)b * SEQ + key) * D_IN + C_IK);
            float4 kv[16];
#pragma unroll
            for (int j = 0; j < 16; ++j) kv[j] = kr[j];
            float s = 0.f;
            asm volatile("" ::: "memory");
#pragma unroll 1
            for (int h = 0; h < 8; ++h) {
                float d = 0.f;
#pragma unroll
                for (int j = 0; j < 16; ++j) { const float4 q4 = *(const float4*)(qi + h * 64 + j * 4);
                    d = fmaf(q4.x, kv[j].x, d); d = fmaf(q4.y, kv[j].y, d); d = fmaf(q4.z, kv[j].z, d); d = fmaf(q4.w, kv[j].w, d); }
                s += fmaxf(d, 0.f) * wv[h];
            }
            sc[key] = s;
        }
        __syncthreads();
        int nsel;
        if (nk <= 256) { for (int i = tid; i < nk; i += 512) sel[i] = i; nsel = nk; }
        else {
            for (int i = tid; i < nk; i += 512) {
                const float si = sc[i]; int rank = 0;
#pragma unroll 4
                for (int j = 0; j < nk; ++j) { const float sj = sc[j]; rank += (sj > si || (sj == si && j < i)) ? 1 : 0; }
                if (rank < 256) sel[rank] = i;
            }
            nsel = 256;
        }
        __syncthreads();
        {
            const int h = wave;
            float lg[4]; float mx = -3.0e38f;
#pragma unroll
            for (int jj = 0; jj < 4; ++jj) {
                const int j = lane + 64 * jj; lg[jj] = -3.0e38f;
                if (j < nsel) {
                    const int key = sel[j];
                    const float4* kr = (const float4*)(proj + ((size_t)b * SEQ + key) * D_IN + C_AK);
                    float d = 0.f;
#pragma unroll
                    for (int q = 0; q < 16; ++q) { const float4 k4 = kr[q]; const float4 q4 = *(const float4*)(qa + h * 64 + q * 4);
                        d = fmaf(q4.x, k4.x, d); d = fmaf(q4.y, k4.y, d); d = fmaf(q4.z, k4.z, d); d = fmaf(q4.w, k4.w, d); }
                    lg[jj] = d * 0.125f + relb[t5_bucket(key - t) * 8 + h];
                    mx = fmaxf(mx, lg[jj]);
                }
            }
            mx = wave_max(mx);
            float sum = 0.f;
#pragma unroll
            for (int jj = 0; jj < 4; ++jj) { const int j = lane + 64 * jj; if (j < nsel) { const float e = expf(lg[jj] - mx); pl[h * 256 + j] = e; sum += e; } }
            sum = wave_sum(sum);
            __builtin_amdgcn_s_waitcnt(0);
            float o = 0.f;
            for (int j = 0; j < nsel; ++j) { const int key = sel[j]; o = fmaf(pl[h * 256 + j], proj[((size_t)b * SEQ + key) * D_IN + C_AV + lane], o); }
            const float z = proj[row * D_IN + C_AZ + h * 64 + lane];
            mix[row * D_MODEL + MX_ATT + h * 64 + lane] = (o / sum) * siluf(z);
        }
    }
}

enum { PH_S5P = 0, PH_NORM, PH_GEMM1, PH_S5, PH_GLUG, PH_GLUE, PH_CONV, PH_SSDSCAN, PH_SSDNORM, PH_DSA, PH_GEMM2, PH_FINAL };

__global__ void __launch_bounds__(512) mk_fwd(Args a) {
    extern __shared__ __attribute__((aligned(16))) float smem[];
    cg::grid_group grid = cg::this_grid();
    phase_s5_params(a);
    for (int l = 0; l < DEPTH; ++l) {
        const float* xcur = (l == 0) ? a.in[0] : a.out;
        phase_rmsnorm(xcur, a.in[1] + (size_t)l * D_MODEL, (float*)(a.ws + WS_HX));
        grid.sync();
        gemm_f32((const float*)(a.ws + WS_HX), D_MODEL, a.in[2] + (size_t)l * D_MODEL * D_IN, D_IN, (float*)(a.ws + WS_PROJ), D_IN, nullptr, 0, M_TOK, D_IN, D_MODEL, smem);
        grid.sync();
        phase_s5(a, l);
        phase_conv(a, l);
        phase_dsa(a, l, smem);
        grid.sync();
        gemm_f32((const float*)(a.ws + WS_MIX) + MX_S5, D_MODEL, a.in[11] + (size_t)l * 512 * 512, 512, (float*)(a.ws + WS_GLU), 512, nullptr, 0, M_TOK, 512, 512, smem);
        phase_ssd_scan(a, l);
        grid.sync();
        phase_glu_ew(a, l);
        phase_ssd_norm(a, l);
        grid.sync();
        gemm_f32((const float*)(a.ws + WS_MIX), D_MODEL, a.in[20] + (size_t)l * D_MODEL * D_MODEL, D_MODEL, a.out, D_MODEL, xcur, D_MODEL, M_TOK, D_MODEL, D_MODEL, smem);
        grid.sync();
    }
    phase_rmsnorm(a.out, a.in[21], a.out);
}

extern "C" void kernel_launch(void* const* d_in, const int* in_sizes, int n_in, void* d_out, int out_size, void* d_ws, size_t ws_size, hipStream_t stream) {
    if (n_in != 22 || out_size != M_TOK * D_MODEL || ws_size < WS_END) {
        fprintf(stderr, "kernel_launch: unexpected problem: n_in %d out %d ws %zu\n", n_in, out_size, ws_size);
        return;
    }
    constexpr size_t kDynLds = 32768;
    static int grid_blocks = 0;
    if (!grid_blocks) {
        int dev = 0, cus = 0, per_cu = 0;
        hipGetDevice(&dev);
        hipDeviceGetAttribute(&cus, hipDeviceAttributeMultiprocessorCount, dev);
        hipOccupancyMaxActiveBlocksPerMultiprocessor(&per_cu, mk_fwd, 512, kDynLds);
        if (per_cu < 1) per_cu = 1;
        if (per_cu > 2) per_cu = 2;
        grid_blocks = cus * per_cu;
    }
    Args a{};
    for (int i = 0; i < 22; ++i) a.in[i] = (const float*)d_in[i];
    a.out = (float*)d_out; a.ws = (unsigned char*)d_ws;
    void* args[] = {&a};
    hipError_t e = hipLaunchCooperativeKernel((void*)mk_fwd, dim3(grid_blocks), dim3(512), args, kDynLds, stream);
    if (e != hipSuccess) fprintf(stderr, "cooperative launch failed: %s (grid %d)\n", hipGetErrorString(e), grid_blocks);
}
```

```cpp
#include <hip/hip_runtime.h>
#include <cstdint>
#include <cstdio>
#include <hip/hip_cooperative_groups.h>
namespace cg = cooperative_groups;

__device__ __forceinline__ int otid() { int t = threadIdx.x; asm volatile("" : "+v"(t)); return t; }
__device__ __forceinline__ int obid() { int b = blockIdx.x; asm volatile("" : "+s"(b)); return b; }
namespace pg8 {
#define PG8_LAS __attribute__((address_space(3)))
typedef unsigned short bf16_t;
typedef short bf16x8 __attribute__((ext_vector_type(8)));
typedef float f32x4 __attribute__((ext_vector_type(4)));
typedef unsigned u32x4 __attribute__((ext_vector_type(4)));
constexpr int BM = 256, BK = 64, HALF = 128, HTB = HALF * BK * 2  , STAGE_BYTES = 8 * HTB, NXCD = 8, WGM = 8;

__host__ __device__ __forceinline__ int lds_byte(int r, int c) { const int st = (r >> 4) * 2 + (c >> 5), rr = r & 15, cc = c & 31, ob = rr * 64 + cc * 2; return st * 1024 + (ob ^ (((ob >> 9) & 1) << 5)); }
__host__ __device__ __forceinline__ void stage_rc(int b, int& R, int& C) { const int st = b / 1024, sb = b % 1024, swz = sb ^ (((sb >> 9) & 1) << 5); R = (st >> 1) * 16 + swz / 64; C = (st & 1) * 32 + (swz % 64) / 2; }
__host__ __device__ __forceinline__ int perm32(int rho) { const int n = rho >> 4, i = rho & 15; return 8 * (i >> 2) + 4 * n + (i & 3); }

struct Unit { int pm, pn; };
struct Gemm { const bf16_t* A; const bf16_t* Bt; int M, N, K; };

struct StaticOrder {
    int nM, nN, nwg, G, c;
    __host__ __device__ void init(int M, int N, int G_, int c_) { nM = M / BM; nN = N / BM; nwg = nM * nN; G = G_; c = c_; }
    __host__ __device__ bool next(int i, Unit& u) const {
        const long L = (long)i * G + c; if (L >= nwg) return false;
        int wgid = (int)L; { const int q = nwg / NXCD, r = nwg % NXCD, xcd = wgid % NXCD, off = wgid / NXCD; wgid = (xcd < r ? xcd * (q + 1) : r * (q + 1) + (xcd - r) * q) + off; }
        const int nig = WGM * nN, gid = wgid / nig, fm = gid * WGM, gsz = (nM - fm) < WGM ? (nM - fm) : WGM;
        u.pm = fm + ((wgid % nig) % gsz); u.pn = (wgid % nig) / gsz; return true;
    }
    __device__ __forceinline__ void a_ready(const Unit&) const {}
    __device__ __forceinline__ void done(const Unit&) const {}
};


__device__ __forceinline__ unsigned cvt_pk_bf16(float lo, float hi) { unsigned r; asm volatile("v_cvt_pk_bf16_f32 %0, %1, %2" : "=v"(r) : "v"(lo), "v"(hi)); return r; }
template <class Epi, class Sched, bool ALIGN_EPI = false, bool SP2 = false>
__device__ __forceinline__ void gemm_phase(PG8_LAS unsigned char* lds, const Gemm g, const Sched& S, const Epi& E) {
    const int tid = otid(), wid = __builtin_amdgcn_readfirstlane(tid >> 6), lane = tid & 63, wr = wid >> 2, wc = wid & 3, fr = lane & 15, fq = lane >> 4;
    const int K = g.K, nt = K / BK;
    unsigned voffA[2], voffB[2];
#pragma unroll
    for (int i = 0; i < 2; ++i) { int R, C; stage_rc(tid * 16 + i * 8192, R, C); const int Rb = Epi::PERM ? ((R & ~31) + perm32(R & 31)) : R;
        voffA[i] = (unsigned)(R * K + C) * 2u; voffB[i] = (unsigned)(Rb * K + C) * 2u; }
    const size_t kstep = (size_t)(BK * 2);
    const size_t hstep = (size_t)HALF * K * 2;
    const size_t tstep = 2 * hstep;
    const unsigned ldsw = (unsigned)wid * 1024u;
    const int aoff = lds_byte(wr * 64 + fr, fq * 8), boff = lds_byte(wc * 32 + fr, fq * 8);
#define PG8_SA(b, h) (((b) * 2 + (h)) * HTB)
#define PG8_SB(b, h) ((4 + (b) * 2 + (h)) * HTB)
#define PG8_STAGE(bufoff, gbase, voff) do { _Pragma("unroll") for (int _i = 0; _i < 2; ++_i) \
        __builtin_amdgcn_global_load_lds((const unsigned*)((const char*)(gbase) + (voff)[_i]), (PG8_LAS unsigned*)(lds + (bufoff) + ldsw + _i * 8192), 16, 0, 0); } while (0)
#define PG8_LDA(dst, b, h) do { _Pragma("unroll") for (int m = 0; m < 4; ++m) _Pragma("unroll") for (int k = 0; k < 2; ++k) dst[m][k] = *(const PG8_LAS bf16x8*)(lds + PG8_SA(b, h) + aoff + m * 2048 + k * 1024); } while (0)
#define PG8_LDB(dst, b, h) do { _Pragma("unroll") for (int n = 0; n < 2; ++n) _Pragma("unroll") for (int k = 0; k < 2; ++k) dst[n][k] = *(const PG8_LAS bf16x8*)(lds + PG8_SB(b, h) + boff + n * 2048 + k * 1024); } while (0)
#define PG8_MMA(ai, bj, At, Bt) do { __builtin_amdgcn_s_setprio(1); _Pragma("unroll") for (int m = 0; m < 4; ++m) _Pragma("unroll") for (int n = 0; n < 2; ++n) _Pragma("unroll") for (int k = 0; k < 2; ++k) \
        acc[ai][bj][m][n] = __builtin_amdgcn_mfma_f32_16x16x32_bf16(Bt[n][k], At[m][k], acc[ai][bj][m][n], 0, 0, 0); __builtin_amdgcn_s_setprio(0); } while (0)
#define PG8_WAIT_V(n) asm volatile("s_waitcnt vmcnt(" #n ")" ::: "memory")
#define PG8_WAIT_L(n) asm volatile("s_waitcnt lgkmcnt(" #n ")" ::: "memory")
#define PG8_BAR __builtin_amdgcn_s_barrier()
#define PG8_SCHED __builtin_amdgcn_sched_barrier(0)
    Unit cur, nxt; int ui = 0;
    if (!S.next(0, cur)) return;
    f32x4 acc[2][2][4][2];
#pragma unroll
    for (int a = 0; a < 2; ++a)
#pragma unroll
        for (int b = 0; b < 2; ++b)
#pragma unroll
            for (int m = 0; m < 4; ++m)
#pragma unroll
                for (int n = 0; n < 2; ++n) acc[a][b][m][n] = (f32x4){0.f, 0.f, 0.f, 0.f};
    bf16x8 At[4][2], B0[2][2], B1[2][2];
    const char* cA = (const char*)g.A + (size_t)cur.pm * tstep; const char* cB = (const char*)g.Bt + (size_t)cur.pn * tstep;
    S.a_ready(cur);
    if constexpr (SP2) {
        PG8_STAGE(PG8_SB(0, 0), cB, voffB); PG8_STAGE(PG8_SB(0, 1), cB + hstep, voffB); PG8_STAGE(PG8_SA(0, 0), cA, voffA); PG8_STAGE(PG8_SA(0, 1), cA + hstep, voffA);
        if (wr == 1) PG8_BAR;
        PG8_WAIT_V(2); PG8_BAR;
        PG8_STAGE(PG8_SB(1, 0), cB + kstep, voffB); PG8_STAGE(PG8_SA(1, 0), cA + kstep, voffA); PG8_STAGE(PG8_SB(1, 1), cB + hstep + kstep, voffB);
        PG8_WAIT_V(6); PG8_BAR;
    } else {
        PG8_STAGE(PG8_SB(0, 0), cB, voffB); PG8_STAGE(PG8_SA(0, 0), cA, voffA); PG8_STAGE(PG8_SB(0, 1), cB + hstep, voffB); PG8_STAGE(PG8_SA(0, 1), cA + hstep, voffA);
        if (wr == 1) PG8_BAR;
        PG8_WAIT_V(4); PG8_BAR;
        PG8_STAGE(PG8_SB(1, 0), cB + kstep, voffB); PG8_STAGE(PG8_SA(1, 0), cA + kstep, voffA); PG8_STAGE(PG8_SB(1, 1), cB + hstep + kstep, voffB);
        PG8_WAIT_V(6); PG8_BAR;
    }
    for (;;) {
        const bool has_next = S.next(ui + 1, nxt);
        const char* nA = has_next ? (const char*)g.A + (size_t)nxt.pm * tstep : cA; const char* nB = has_next ? (const char*)g.Bt + (size_t)nxt.pn * tstep : cB;
        for (int t = 0; t < nt; t += 2) {
            const bool last = (t == nt - 2);
            const char* a1 = cA + (size_t)(t + 1) * kstep;
            const char* a2 = last ? nA : cA + (size_t)(t + 2) * kstep; const char* b2 = last ? nB : cB + (size_t)(t + 2) * kstep;
            const char* a3 = a2 + kstep; const char* b3 = b2 + kstep;
            if (last && has_next) S.a_ready(nxt);
            if constexpr (SP2) {
            PG8_LDB(B0, 0, 0); PG8_LDB(B1, 0, 1); PG8_SCHED; PG8_LDA(At, 0, 0); PG8_STAGE(PG8_SA(1, 1), a1 + hstep, voffA);
            PG8_WAIT_V(8); PG8_WAIT_L(0); PG8_BAR; PG8_MMA(0, 0, At, B0); PG8_MMA(0, 1, At, B1); PG8_BAR; PG8_SCHED;
            PG8_LDA(At, 0, 1); PG8_STAGE(PG8_SB(0, 0), b2, voffB); PG8_STAGE(PG8_SB(0, 1), b2 + hstep, voffB); PG8_STAGE(PG8_SA(0, 0), a2, voffA);
            PG8_WAIT_V(8); PG8_WAIT_L(0); PG8_BAR; PG8_MMA(1, 0, At, B0); PG8_MMA(1, 1, At, B1); PG8_BAR; PG8_SCHED;
            PG8_LDB(B0, 1, 0); PG8_LDB(B1, 1, 1); PG8_SCHED; PG8_LDA(At, 1, 0); PG8_STAGE(PG8_SA(0, 1), a2 + hstep, voffA);
            PG8_WAIT_V(8); PG8_WAIT_L(0); PG8_BAR; PG8_MMA(0, 0, At, B0); PG8_MMA(0, 1, At, B1); PG8_BAR; PG8_SCHED;
            PG8_LDA(At, 1, 1); PG8_STAGE(PG8_SB(1, 0), b3, voffB); PG8_STAGE(PG8_SB(1, 1), b3 + hstep, voffB); PG8_STAGE(PG8_SA(1, 0), a3, voffA);
            PG8_WAIT_V(8); PG8_WAIT_L(0); PG8_BAR; PG8_MMA(1, 0, At, B0); PG8_MMA(1, 1, At, B1); PG8_BAR; PG8_SCHED;
            } else {
            PG8_LDB(B0, 0, 0); PG8_SCHED; PG8_LDA(At, 0, 0); PG8_STAGE(PG8_SA(1, 1), a1 + hstep, voffA);
            PG8_WAIT_L(8); PG8_BAR; PG8_WAIT_L(0); PG8_MMA(0, 0, At, B0); PG8_BAR; PG8_SCHED;
            PG8_LDB(B1, 0, 1); PG8_STAGE(PG8_SB(0, 0), b2, voffB);
            PG8_BAR; PG8_WAIT_L(0); PG8_MMA(0, 1, At, B1); PG8_BAR;
            PG8_LDA(At, 0, 1); PG8_STAGE(PG8_SA(0, 0), a2, voffA);
            PG8_BAR; PG8_WAIT_L(0); PG8_MMA(1, 0, At, B0); PG8_BAR; PG8_SCHED;
            PG8_STAGE(PG8_SB(0, 1), b2 + hstep, voffB);
            PG8_WAIT_V(6); PG8_BAR; PG8_MMA(1, 1, At, B1); PG8_BAR;
            PG8_LDB(B0, 1, 0); PG8_SCHED; PG8_LDA(At, 1, 0); PG8_STAGE(PG8_SA(0, 1), a2 + hstep, voffA);
            PG8_WAIT_L(8); PG8_BAR; PG8_WAIT_L(0); PG8_MMA(0, 0, At, B0); PG8_BAR; PG8_SCHED;
            PG8_LDB(B1, 1, 1); PG8_STAGE(PG8_SB(1, 0), b3, voffB);
            PG8_BAR; PG8_WAIT_L(0); PG8_MMA(0, 1, At, B1); PG8_BAR;
            PG8_LDA(At, 1, 1); PG8_STAGE(PG8_SA(1, 0), a3, voffA);
            PG8_BAR; PG8_WAIT_L(0); PG8_MMA(1, 0, At, B0); PG8_BAR; PG8_SCHED;
            PG8_STAGE(PG8_SB(1, 1), b3 + hstep, voffB);
            PG8_WAIT_V(6); PG8_BAR; PG8_MMA(1, 1, At, B1); PG8_BAR;
            }
        }
        if constexpr (ALIGN_EPI) { if (wr == 0) PG8_BAR; }
        if constexpr (!Epi::AFTER_DRAIN) { E(acc, cur, wr, wc, fr, fq); S.done(cur); }
        if (!has_next) break;
#pragma unroll
        for (int a = 0; a < 2; ++a)
#pragma unroll
            for (int b = 0; b < 2; ++b)
#pragma unroll
                for (int m = 0; m < 4; ++m)
#pragma unroll
                    for (int n = 0; n < 2; ++n) acc[a][b][m][n] = (f32x4){0.f, 0.f, 0.f, 0.f};
        cur = nxt; cA = nA; cB = nB; ++ui;
        if constexpr (ALIGN_EPI) { if (wr == 1) PG8_BAR; }
    }
    PG8_WAIT_V(0);
    if constexpr (!ALIGN_EPI) { if (wr == 0) PG8_BAR; }
    PG8_BAR;
    if constexpr (Epi::AFTER_DRAIN) { E.fused(acc, cur, wr, wc, fr, fq, lds, wid, lane); S.done(cur); }
#undef PG8_SA
#undef PG8_SB
#undef PG8_STAGE
#undef PG8_LDA
#undef PG8_LDB
#undef PG8_MMA
#undef PG8_WAIT_V
#undef PG8_WAIT_L
#undef PG8_BAR
#undef PG8_SCHED
}
}

constexpr int D_MODEL = 2048, BATCH = 4, SEQ = 2048, DEPTH = 2;
constexpr int M_TOK = BATCH * SEQ;
constexpr int D_IN = 5848;
constexpr float EPS = 1e-6f;
constexpr int PP = 5888;
constexpr int P_S5U = 0, P_S5Z = 512, P_SSDZ = 1024, P_XBC = 2048, P_AQ = 4096, P_IQ = 4608, P_AZ = 5120, P_AK = 5632, P_AV = 5696, P_IK = 5760, P_DT = 5824, P_IW = 5840;
constexpr int MX_S5 = 0, MX_SSD = 512, MX_ATT = 1536;

typedef unsigned short bf16;
typedef unsigned u32x4 __attribute__((ext_vector_type(4)));
typedef unsigned u32x2 __attribute__((ext_vector_type(2)));
typedef float f32x4 __attribute__((ext_vector_type(4)));
#define LAS __attribute__((address_space(3)))

constexpr size_t MiB = 1u << 20;
constexpr size_t WS_CTL = 0;
constexpr size_t WS_WIN = 2 * MiB;
constexpr size_t WIN_L = (size_t)PP * 2048 * 2;
constexpr size_t WS_WOUT = 48 * MiB;
constexpr size_t WOUT_L = (size_t)2048 * 2048 * 2;
constexpr size_t WS_WGLU = 64 * MiB;
constexpr size_t WGLU_L = (size_t)512 * 512 * 2;
constexpr size_t WS_S5P = 65 * MiB;
constexpr size_t WS_SIDE = 66 * MiB;
constexpr size_t WS_XB = 68 * MiB;
constexpr size_t WS_PROJ = 100 * MiB;
constexpr size_t WS_MIX = 192 * MiB;
constexpr size_t WS_YG = 224 * MiB;
constexpr size_t WS_DTS = 67 * MiB;
constexpr size_t WS_CS = WS_DTS + 512 * 1024;
constexpr size_t WS_XC = 232 * MiB;
constexpr size_t WS_XT1 = 264 * MiB;
constexpr size_t WS_XT2 = 280 * MiB;
constexpr size_t WS_BTR = 296 * MiB;
constexpr size_t WS_CST = 304 * MiB;
constexpr size_t WS_SSQ = 336 * MiB;
constexpr size_t WS_BTAB = 336 * MiB + 512 * 1024;
constexpr size_t WS_VT = 337 * MiB;
constexpr size_t WS_END = 338 * MiB;
static_assert(WS_WIN + 2 * WIN_L <= WS_WOUT && WS_WOUT + 2 * WOUT_L <= WS_WGLU, "ws map");

struct Args {
    const float* in[22];
    float* out;
    unsigned char* ws;
};

__device__ __forceinline__ float bf2f(unsigned v) { return __uint_as_float(v << 16); }
__device__ __forceinline__ unsigned f2bf(float f) { unsigned u = __float_as_uint(f); return (u + 0x7fffu + ((u >> 16) & 1u)) >> 16; }
__device__ __forceinline__ unsigned pk2(float lo, float hi) { return f2bf(lo) | (f2bf(hi) << 16); }
__device__ __forceinline__ float4 ldbf4(const bf16* p) { const u32x2 u = *(const u32x2*)p; float4 r; r.x = __uint_as_float(u.x << 16); r.y = __uint_as_float(u.x & 0xffff0000u); r.z = __uint_as_float(u.y << 16); r.w = __uint_as_float(u.y & 0xffff0000u); return r; }
__device__ __forceinline__ void unpack8(const u32x4 u, float* f) {
    f[0] = __uint_as_float(u.x << 16); f[1] = __uint_as_float(u.x & 0xffff0000u); f[2] = __uint_as_float(u.y << 16); f[3] = __uint_as_float(u.y & 0xffff0000u);
    f[4] = __uint_as_float(u.z << 16); f[5] = __uint_as_float(u.z & 0xffff0000u); f[6] = __uint_as_float(u.w << 16); f[7] = __uint_as_float(u.w & 0xffff0000u);
}

__device__ __forceinline__ float wave_sum(float v) {
#pragma unroll
    for (int o = 1; o < 64; o <<= 1) v += __shfl_xor(v, o);
    return v;
}
__device__ __forceinline__ float wave_max(float v) {
#pragma unroll
    for (int o = 1; o < 64; o <<= 1) v = fmaxf(v, __shfl_xor(v, o));
    return v;
}
__device__ __forceinline__ float siluf(float x) { return x / (1.0f + expf(-x)); }
__device__ __forceinline__ float sigmoidf_(float x) { return 1.0f / (1.0f + expf(-x)); }
__device__ __forceinline__ float gelu_tanh(float x) { return 0.5f * x * (1.0f + tanhf(0.7978845608028654f * (x + 0.044715f * x * x * x))); }
__device__ __forceinline__ float softplusf_(float x) { return fmaxf(x, 0.f) + log1pf(expf(-fabsf(x))); }

struct EpiProj {
    static constexpr bool PERM = true, AFTER_DRAIN = false;
    bf16* P; float* side; bf16* VT;
    __device__ __forceinline__ void operator()(const pg8::f32x4 (&acc)[2][2][4][2], const pg8::Unit& u, int wr, int wc, int fr, int fq) const {
        const int row0 = u.pm * 256 + wr * 64 + fr, col0 = u.pn * 256 + wc * 32 + 8 * fq;
        const bool sidew = (u.pn == 22) && (wc == 2) && (fq < 3);
        const bool vtw = (u.pn == 22) && (wc >= 2);
#pragma unroll
        for (int ai = 0; ai < 2; ++ai)
#pragma unroll
            for (int m = 0; m < 4; ++m) {
                const int row = row0 + ai * 128 + m * 16;
                bf16* rowp = P + (size_t)row * PP + col0;
#pragma unroll
                for (int bj = 0; bj < 2; ++bj) {
                    const pg8::f32x4 v0 = acc[ai][bj][m][0], v1 = acc[ai][bj][m][1];
                    u32x4 w; w.x = pg8::cvt_pk_bf16(v0[0], v0[1]); w.y = pg8::cvt_pk_bf16(v0[2], v0[3]); w.z = pg8::cvt_pk_bf16(v1[0], v1[1]); w.w = pg8::cvt_pk_bf16(v1[2], v1[3]);
                    *(u32x4*)(rowp + bj * 128) = w;
                    if (bj == 1 && sidew) { float* sp = side + (size_t)row * 32 + 8 * fq; *(pg8::f32x4*)sp = v0; *(pg8::f32x4*)(sp + 4) = v1; }
                    if (bj == 0 && vtw) { bf16* vp = VT + ((size_t)(row >> 11) * 64 + (wc - 2) * 32 + 8 * fq) * 2048 + (row & 2047);
#pragma unroll
                        for (int e = 0; e < 4; ++e) { vp[(size_t)e * 2048] = (bf16)f2bf(v0[e]); vp[(size_t)(4 + e) * 2048] = (bf16)f2bf(v1[e]); } }
                }
            }
    }
};
struct EpiOut {
    static constexpr bool PERM = false, AFTER_DRAIN = false;
    const float* base; float* out;
    __device__ __forceinline__ void operator()(const pg8::f32x4 (&acc)[2][2][4][2], const pg8::Unit& u, int wr, int wc, int fr, int fq) const {
        const int col0 = u.pn * 256 + wc * 32 + 4 * fq;
#pragma unroll
        for (int ai = 0; ai < 2; ++ai)
#pragma unroll
            for (int m = 0; m < 4; ++m) {
                const int r = u.pm * 256 + ai * 128 + wr * 64 + m * 16 + fr; const size_t off = (size_t)r * D_MODEL + col0;
#pragma unroll
                for (int bj = 0; bj < 2; ++bj)
#pragma unroll
                    for (int n = 0; n < 2; ++n) { const pg8::f32x4 bs = *(const pg8::f32x4*)(base + off + bj * 128 + n * 16); *(pg8::f32x4*)(out + off + bj * 128 + n * 16) = bs + acc[ai][bj][m][n]; }
            }
    }
};
struct EpiGlu {
    static constexpr bool PERM = true, AFTER_DRAIN = false;
    const bf16* yg; const bf16* proj; const float* gb; bf16* mix;
    __device__ __forceinline__ void operator()(const pg8::f32x4 (&acc)[2][2][4][2], const pg8::Unit& u, int wr, int wc, int fr, int fq) const {
        const int row0 = u.pm * 256 + wr * 64 + fr, col0 = u.pn * 256 + wc * 32 + 8 * fq;
#pragma unroll
        for (int ai = 0; ai < 2; ++ai)
#pragma unroll
            for (int m = 0; m < 4; ++m) {
                const int row = row0 + ai * 128 + m * 16;
#pragma unroll
                for (int bj = 0; bj < 2; ++bj) {
                    const int c = col0 + bj * 128;
                    float y[8], z[8], o[8];
                    unpack8(*(const u32x4*)(yg + (size_t)row * 512 + c), y);
                    unpack8(*(const u32x4*)(proj + (size_t)row * PP + P_S5Z + c), z);
                    const pg8::f32x4 b0 = *(const pg8::f32x4*)(gb + c), b1 = *(const pg8::f32x4*)(gb + c + 4);
                    const pg8::f32x4 v0 = acc[ai][bj][m][0] + b0, v1 = acc[ai][bj][m][1] + b1;
#pragma unroll
                    for (int j = 0; j < 4; ++j) { o[j] = y[j] * sigmoidf_(v0[j]) * siluf(z[j]); o[4 + j] = y[4 + j] * sigmoidf_(v1[j]) * siluf(z[4 + j]); }
                    u32x4 w; w.x = pk2(o[0], o[1]); w.y = pk2(o[2], o[3]); w.z = pk2(o[4], o[5]); w.w = pk2(o[6], o[7]);
                    *(u32x4*)(mix + (size_t)row * D_MODEL + MX_S5 + c) = w;
                }
            }
    }
};

__device__ __forceinline__ int win_src_col(int n) {
    if (n < 4096) return n;
    if (n < 4608) return n - 4096 + 4112;
    if (n < 5120) return n - 4608 + 4752;
    if (n < 5632) return n - 5120 + 5336;
    if (n < 5696) return n - 5632 + 4624;
    if (n < 5760) return n - 5696 + 4688;
    if (n < 5824) return n - 5760 + 5264;
    if (n < 5840) return n - 5824 + 4096;
    if (n < 5848) return n - 5840 + 5328;
    return -1;
}
template <int MODE>
__device__ __forceinline__ void transpose_item(const float* W, int K, int Nsrc, bf16* WT, float* scr, int kb, int nb, int lane) {
    const int k0 = 64 * kb, n0 = 32 * nb;
    const int nsrc = (MODE == 1) ? win_src_col(n0 + (lane & 31)) : (n0 + (lane & 31));
#pragma unroll 8
    for (int i = 0; i < 32; ++i) { const int kk = 2 * i + (lane >> 5); scr[kk * 33 + (lane & 31)] = (nsrc >= 0) ? W[(size_t)(k0 + kk) * Nsrc + nsrc] : 0.f; }
    asm volatile("s_waitcnt lgkmcnt(0)" ::: "memory");
    const int c = lane & 7;
#pragma unroll
    for (int j = 0; j < 4; ++j) { const int n = (lane >> 3) + 8 * j; const float* s = scr + (8 * c) * 33 + n;
        u32x4 o; o.x = pk2(s[0 * 33], s[1 * 33]); o.y = pk2(s[2 * 33], s[3 * 33]); o.z = pk2(s[4 * 33], s[5 * 33]); o.w = pk2(s[6 * 33], s[7 * 33]);
        *(u32x4*)(WT + (size_t)(n0 + n) * K + k0 + 8 * c) = o; }
    asm volatile("s_waitcnt lgkmcnt(0)" ::: "memory");
}

constexpr size_t S5P_LAM = 0, S5P_BBT = 64 * 1024, S5P_CT = 64 * 1024 + 256 * 1024;
__device__ __forceinline__ void phase_s5_params(const Args& a) {
    float* lam = (float*)(a.ws + WS_S5P + S5P_LAM);
    bf16* BBT = (bf16*)(a.ws + WS_S5P + S5P_BBT);
    bf16* CT = (bf16*)(a.ws + WS_S5P + S5P_CT);
    const int gt = obid() * 512 + otid();
    if (gt >= 2 * 32 * 64) return;
    const int l = gt / 2048, g = (gt / 64) % 32, p = gt % 64;
    const float A_re = a.in[3][gt], A_im = a.in[4][gt];
    const float dt = expf(a.in[5][l * 32 + g]);
    const float lre = fminf(A_re, -1e-4f), lim = A_im;
    const float mag = expf(lre * dt);
    const float lbr = mag * cosf(lim * dt), lbi = mag * sinf(lim * dt);
    const float nr = lbr - 1.0f, ni = lbi;
    const float den = lre * lre + lim * lim;
    const float fr = (nr * lre + ni * lim) / den, fi = (ni * lre - nr * lim) / den;
    lam[gt * 2] = lbr; lam[gt * 2 + 1] = lbi;
    for (int c = 0; c < 16; ++c) {
        const float Bre = a.in[6][gt * 16 + c], Bim = a.in[7][gt * 16 + c];
        BBT[((size_t)(l * 32 + g) * 128 + p) * 16 + c] = (bf16)f2bf(fr * Bre - fi * Bim);
        BBT[((size_t)(l * 32 + g) * 128 + 64 + p) * 16 + c] = (bf16)f2bf(fr * Bim + fi * Bre);
        CT[((size_t)(l * 32 + g) * 16 + c) * 128 + p] = (bf16)f2bf(a.in[8][((size_t)(l * 32 + g) * 16 + c) * 64 + p]);
        CT[((size_t)(l * 32 + g) * 16 + c) * 128 + 64 + p] = (bf16)f2bf(-a.in[9][((size_t)(l * 32 + g) * 16 + c) * 64 + p]);
    }
}

__device__ __forceinline__ void phase_rmsnorm_bf16(const float* X, const float* w, bf16* XB) {
    const int wave = otid() >> 6, lane = otid() & 63;
    const int nw = blockDim.x >> 6;
    for (int row = obid() * nw + wave; row < M_TOK; row += gridDim.x * nw) {
        const float4* xr = (const float4*)(X + (size_t)row * D_MODEL);
        float4 v[8]; float s = 0.f;
#pragma unroll
        for (int j = 0; j < 8; ++j) { v[j] = xr[lane + 64 * j]; s += v[j].x * v[j].x + v[j].y * v[j].y + v[j].z * v[j].z + v[j].w * v[j].w; }
        s = wave_sum(s);
        const float rs = 1.0f / sqrtf(s * (1.0f / D_MODEL) + EPS);
        u32x2* hr = (u32x2*)(XB + (size_t)row * D_MODEL);
#pragma unroll
        for (int j = 0; j < 8; ++j) { const float4 ww = ((const float4*)w)[lane + 64 * j];
            u32x2 o; o.x = pk2(v[j].x * rs * ww.x, v[j].y * rs * ww.y); o.y = pk2(v[j].z * rs * ww.z, v[j].w * rs * ww.w); hr[lane + 64 * j] = o; }
    }
}
__device__ __forceinline__ void phase_rmsnorm_f32(const float* X, const float* w, float* H) {
    const int wave = otid() >> 6, lane = otid() & 63;
    const int nw = blockDim.x >> 6;
    for (int row = obid() * nw + wave; row < M_TOK; row += gridDim.x * nw) {
        const float4* xr = (const float4*)(X + (size_t)row * D_MODEL);
        float4 v[8]; float s = 0.f;
#pragma unroll
        for (int j = 0; j < 8; ++j) { v[j] = xr[lane + 64 * j]; s += v[j].x * v[j].x + v[j].y * v[j].y + v[j].z * v[j].z + v[j].w * v[j].w; }
        s = wave_sum(s);
        const float rs = 1.0f / sqrtf(s * (1.0f / D_MODEL) + EPS);
        float4* hr = (float4*)(H + (size_t)row * D_MODEL);
#pragma unroll
        for (int j = 0; j < 8; ++j) { const float4 ww = ((const float4*)w)[lane + 64 * j];
            float4 o; o.x = v[j].x * rs * ww.x; o.y = v[j].y * rs * ww.y; o.z = v[j].z * rs * ww.z; o.w = v[j].w * rs * ww.w; hr[lane + 64 * j] = o; }
    }
}

__device__ __forceinline__ void phase_prologue(const Args& a, float* smem) {
    const int wave = otid() >> 6, lane = otid() & 63;
    float* scr = smem + wave * 4096;
    const int gw = obid() * 8 + wave, NGW = gridDim.x * 8;
    constexpr int I_IN = 32 * (PP / 32), I_OUT = 32 * 64, I_GLU = 8 * 16;
    constexpr int NIT = 2 * (I_IN + I_OUT + I_GLU);
    for (int it = gw; it < NIT; it += NGW) {
        int r = it; const int l = r / (I_IN + I_OUT + I_GLU); r -= l * (I_IN + I_OUT + I_GLU);
        if (r < I_IN) { transpose_item<1>(a.in[2] + (size_t)l * D_MODEL * D_IN, 2048, D_IN, (bf16*)(a.ws + WS_WIN + l * WIN_L), scr, r / (PP / 32), r % (PP / 32), lane); continue; }
        r -= I_IN;
        if (r < I_OUT) { transpose_item<0>(a.in[20] + (size_t)l * D_MODEL * D_MODEL, 2048, 2048, (bf16*)(a.ws + WS_WOUT + l * WOUT_L), scr, r / 64, r % 64, lane); continue; }
        r -= I_OUT;
        transpose_item<0>(a.in[11] + (size_t)l * 512 * 512, 512, 512, (bf16*)(a.ws + WS_WGLU + l * WGLU_L), scr, r / 16, r % 16, lane);
    }
    phase_s5_params(a);
    phase_rmsnorm_bf16(a.in[0], a.in[1], (bf16*)(a.ws + WS_XB));
}

typedef short bf16x8 __attribute__((ext_vector_type(8)));
typedef float f32x16 __attribute__((ext_vector_type(16)));
#define MFMA32(a, b, c) __builtin_amdgcn_mfma_f32_32x32x16_bf16((a), (b), (c), 0, 0, 0)
#define MFMA16(a, b, c) __builtin_amdgcn_mfma_f32_16x16x32_bf16((a), (b), (c), 0, 0, 0)
__device__ __forceinline__ int crow(int r, int hh) { return (r & 3) + 8 * (r >> 2) + 4 * hh; }
__device__ __forceinline__ bf16x8 ld16(const bf16* p) { return *(const bf16x8*)p; }
__device__ __forceinline__ bf16x8 ld8x2(const bf16* p0, const bf16* p1) { const u32x2 x = *(const u32x2*)p0, y = *(const u32x2*)p1; const u32x4 v = {x.x, x.y, y.x, y.y}; return __builtin_bit_cast(bf16x8, v); }
__device__ __forceinline__ f32x16 zero16() { f32x16 z;
#pragma unroll
    for (int i = 0; i < 16; ++i) z[i] = 0.f; return z; }

template <bool OUT>
__device__ __forceinline__ void s5_tile(const bf16* proj, bf16* yg, float* T, size_t row0, int g, int lane, const bf16x8 (&bb)[4], const bf16x8 (&ct)[4], float ar, float ai, float dd, float& xr, float& xi) {
    const int r = lane & 31, hh = lane >> 5, cc = lane & 15, q4 = lane >> 4;
    const bf16x8 uf = ld16(proj + (row0 + r) * PP + P_S5U + g * 16 + 8 * hh);
#pragma unroll
    for (int nb = 0; nb < 4; ++nb) {
        const f32x16 acc = MFMA32(uf, bb[nb], zero16());
#pragma unroll
        for (int rg = 0; rg < 16; ++rg) T[crow(rg, hh) * 132 + nb * 32 + r] = acc[rg];
    }
    asm volatile("s_waitcnt lgkmcnt(0)" ::: "memory");
#pragma unroll 8
    for (int t = 0; t < 32; ++t) {
        const float bur = T[t * 132 + lane], bui = T[t * 132 + 64 + lane];
        const float nxr = fmaf(ar, xr, fmaf(-ai, xi, bur));
        const float nxi = fmaf(ar, xi, fmaf(ai, xr, bui));
        xr = nxr; xi = nxi;
        if (OUT) { T[t * 132 + lane] = xr; T[t * 132 + 64 + lane] = xi; }
    }
    if (OUT) {
        asm volatile("s_waitcnt lgkmcnt(0)" ::: "memory");
#pragma unroll
        for (int mt = 0; mt < 2; ++mt) {
            f32x4 y = {0.f, 0.f, 0.f, 0.f};
#pragma unroll
            for (int kk = 0; kk < 4; ++kk) {
                const float* tp = T + (mt * 16 + cc) * 132 + kk * 32 + 8 * q4;
                const float4 f0 = *(const float4*)tp, f1 = *(const float4*)(tp + 4);
                u32x4 av; av.x = pk2(f0.x, f0.y); av.y = pk2(f0.z, f0.w); av.z = pk2(f1.x, f1.y); av.w = pk2(f1.z, f1.w);
                y = MFMA16(__builtin_bit_cast(bf16x8, av), ct[kk], y);
            }
#pragma unroll
            for (int rg = 0; rg < 4; ++rg) {
                const size_t row = row0 + mt * 16 + q4 * 4 + rg;
                const float ul = bf2f(proj[row * PP + P_S5U + g * 16 + cc]);
                yg[row * 512 + g * 16 + cc] = (bf16)f2bf(gelu_tanh(y[rg] + dd * ul));
            }
        }
    }
    asm volatile("s_waitcnt lgkmcnt(0)" ::: "memory");
}

__device__ __forceinline__ void phase_s5(const Args& a, int l, float* smem) {
    const bf16* proj = (const bf16*)(a.ws + WS_PROJ);
    bf16* yg = (bf16*)(a.ws + WS_YG);
    const float* lam = (const float*)(a.ws + WS_S5P + S5P_LAM) + (size_t)l * 32 * 64 * 2;
    const bf16* BBT = (const bf16*)(a.ws + WS_S5P + S5P_BBT) + (size_t)l * 32 * 128 * 16;
    const bf16* CT = (const bf16*)(a.ws + WS_S5P + S5P_CT) + (size_t)l * 32 * 16 * 128;
    const float* Dp = a.in[10] + (size_t)l * 512;
    const int tid = otid(), wave = tid >> 6, lane = tid & 63, r = lane & 31, hh = lane >> 5, cc = lane & 15, q4 = lane >> 4;
    float* T = smem + wave * 4224;
    float* segend = smem + 8 * 4224;
    for (int unit = obid(); unit < BATCH * 32; unit += gridDim.x) {
        const int b = unit >> 5, g = unit & 31;
        const float ar = lam[(g * 64 + lane) * 2], ai = lam[(g * 64 + lane) * 2 + 1];
        bf16x8 bb[4], ct[4];
#pragma unroll
        for (int nb = 0; nb < 4; ++nb) bb[nb] = ld16(BBT + ((size_t)(g * 128 + nb * 32 + r)) * 16 + 8 * hh);
#pragma unroll
        for (int kk = 0; kk < 4; ++kk) ct[kk] = ld16(CT + ((size_t)(g * 16 + cc)) * 128 + kk * 32 + 8 * q4);
        const float dd = Dp[g * 16 + cc];
        __syncthreads();
        float xr = 0.f, xi = 0.f;
        const size_t rowb = (size_t)b * SEQ + wave * 256;
#pragma unroll 1
        for (int tile = 0; tile < 8; ++tile) s5_tile<false>(proj, yg, T, rowb + tile * 32, g, lane, bb, ct, ar, ai, dd, xr, xi);
        segend[wave * 128 + lane] = xr; segend[wave * 128 + 64 + lane] = xi;
        __syncthreads();
        float pr = ar, pi = ai;
#pragma unroll
        for (int i = 0; i < 8; ++i) { const float t = pr * pr - pi * pi; pi = 2.f * pr * pi; pr = t; }
        float cr = 0.f, ci = 0.f;
        for (int w2 = 0; w2 < wave; ++w2) { const float sr = segend[w2 * 128 + lane], si = segend[w2 * 128 + 64 + lane]; const float t = pr * cr - pi * ci + sr; ci = pr * ci + pi * cr + si; cr = t; }
        xr = cr; xi = ci;
#pragma unroll 1
        for (int tile = 0; tile < 8; ++tile) s5_tile<true>(proj, yg, T, rowb + tile * 32, g, lane, bb, ct, ar, ai, dd, xr, xi);
    }
}


__device__ __forceinline__ void phase_ssd_pre(const Args& a, int l, float* smem) {
    const bf16* proj = (const bf16*)(a.ws + WS_PROJ);
    const float* side = (const float*)(a.ws + WS_SIDE);
    float* DTS = (float*)(a.ws + WS_DTS); float* CS = (float*)(a.ws + WS_CS);
    bf16* XC = (bf16*)(a.ws + WS_XC); bf16* XT1 = (bf16*)(a.ws + WS_XT1); bf16* XT2 = (bf16*)(a.ws + WS_XT2); bf16* BTR = (bf16*)(a.ws + WS_BTR);
    const float* cw = a.in[13] + (size_t)l * 4 * 2048;
    const float* cb = a.in[14] + (size_t)l * 2048;
    float* dtl = smem; float* csl = smem + 1024;
    const int tid = otid(), wave = tid >> 6, lane = tid & 63;
    for (int u = obid(); u < 512; u += gridDim.x) {
        const int b = u >> 7, c = (u >> 2) & 31, q = u & 3;
        const size_t row0 = (size_t)b * SEQ + c * 64;
        __syncthreads();
#pragma unroll
        for (int k = 0; k < 2; ++k) {
            const int h = wave * 2 + k;
            const float dtv = softplusf_(side[(row0 + lane) * 32 + h] + a.in[15][l * 16 + h]);
            float v = dtv * (-expf(a.in[16][l * 16 + h]));
#pragma unroll
            for (int o = 1; o < 64; o <<= 1) { const float t = __shfl_up(v, o); if (lane >= o) v += t; }
            dtl[lane * 16 + h] = dtv; csl[lane * 16 + h] = v;
            if (q == 0) { DTS[(row0 + lane) * 16 + h] = dtv; CS[(row0 + lane) * 16 + h] = v; }
        }
        __syncthreads();
        const int cp = tid & 255, th = tid >> 8, ch = q * 512 + 2 * cp;
        float w0[4], w1[4];
#pragma unroll
        for (int k = 0; k < 4; ++k) { w0[k] = cw[k * 2048 + ch]; w1[k] = cw[k * 2048 + ch + 1]; }
        const float b0 = cb[ch], b1 = cb[ch + 1];
        const bf16* pcol = proj + P_XBC + ch;
        float xa[11], xb[11];
#pragma unroll
        for (int i = 0; i < 3; ++i) {
            const int t = th * 32 - 3 + i;
            unsigned v = 0u; if (c * 64 + t >= 0) v = *(const unsigned*)(pcol + (row0 + t) * PP);
            xa[i] = __uint_as_float(v << 16); xb[i] = __uint_as_float(v & 0xffff0000u);
        }
        const int hx = ch >> 6;
#pragma unroll 1
        for (int grp = 0; grp < 4; ++grp) {
            const int t0 = th * 32 + grp * 8;
#pragma unroll
            for (int i = 0; i < 8; ++i) { const unsigned v = *(const unsigned*)(pcol + (row0 + t0 + i) * PP); xa[3 + i] = __uint_as_float(v << 16); xb[3 + i] = __uint_as_float(v & 0xffff0000u); }
            float ya[8], yb[8];
#pragma unroll
            for (int i = 0; i < 8; ++i) {
                float s0 = b0, s1 = b1;
#pragma unroll
                for (int k = 0; k < 4; ++k) { s0 = fmaf(w0[k], xa[i + k], s0); s1 = fmaf(w1[k], xb[i + k], s1); }
                ya[i] = siluf(s0); yb[i] = siluf(s1);
                *(unsigned*)(XC + (row0 + t0 + i) * 2048 + ch) = pk2(ya[i], yb[i]);
            }
            if (q < 2) {
                bf16* d1 = XT1 + ((size_t)b * 1024 + ch) * 2048 + c * 64 + t0;
                bf16* d2 = XT2 + ((size_t)b * 1024 + ch) * 2048 + c * 64 + t0;
                u32x4 o; o.x = pk2(ya[0], ya[1]); o.y = pk2(ya[2], ya[3]); o.z = pk2(ya[4], ya[5]); o.w = pk2(ya[6], ya[7]); *(u32x4*)d1 = o;
                o.x = pk2(yb[0], yb[1]); o.y = pk2(yb[2], yb[3]); o.z = pk2(yb[4], yb[5]); o.w = pk2(yb[6], yb[7]); *(u32x4*)(d1 + 2048) = o;
                float wg[8]; const float cend = csl[63 * 16 + hx];
#pragma unroll
                for (int i = 0; i < 8; ++i) wg[i] = dtl[(t0 + i) * 16 + hx] * expf(cend - csl[(t0 + i) * 16 + hx]);
                o.x = pk2(ya[0] * wg[0], ya[1] * wg[1]); o.y = pk2(ya[2] * wg[2], ya[3] * wg[3]); o.z = pk2(ya[4] * wg[4], ya[5] * wg[5]); o.w = pk2(ya[6] * wg[6], ya[7] * wg[7]); *(u32x4*)d2 = o;
                o.x = pk2(yb[0] * wg[0], yb[1] * wg[1]); o.y = pk2(yb[2] * wg[2], yb[3] * wg[3]); o.z = pk2(yb[4] * wg[4], yb[5] * wg[5]); o.w = pk2(yb[6] * wg[6], yb[7] * wg[7]); *(u32x4*)(d2 + 2048) = o;
            } else if (q == 2) {
                bf16* d1 = BTR + ((size_t)b * 512 + (ch - 1024)) * 2048 + c * 64 + t0;
                u32x4 o; o.x = pk2(ya[0], ya[1]); o.y = pk2(ya[2], ya[3]); o.z = pk2(ya[4], ya[5]); o.w = pk2(ya[6], ya[7]); *(u32x4*)d1 = o;
                o.x = pk2(yb[0], yb[1]); o.y = pk2(yb[2], yb[3]); o.z = pk2(yb[4], yb[5]); o.w = pk2(yb[6], yb[7]); *(u32x4*)(d1 + 2048) = o;
            }
#pragma unroll
            for (int i = 0; i < 3; ++i) { xa[i] = xa[8 + i]; xb[i] = xb[8 + i]; }
        }
    }
}

__device__ __forceinline__ void phase_ssd1(const Args& a) {
    const bf16* XT2 = (const bf16*)(a.ws + WS_XT2); const bf16* BTR = (const bf16*)(a.ws + WS_BTR); bf16* CST = (bf16*)(a.ws + WS_CST);
    const int tid = otid(), wave = tid >> 6, lane = tid & 63, r = lane & 31, hh = lane >> 5;
    for (int u = obid() * 8 + wave; u < 2048; u += gridDim.x * 8) {
        const int b = u >> 9, c = (u >> 4) & 31, h = u & 15, g = h >> 2;
        bf16x8 af[2][4];
#pragma unroll
        for (int pb = 0; pb < 2; ++pb)
#pragma unroll
            for (int kk = 0; kk < 4; ++kk) af[pb][kk] = ld16(XT2 + ((size_t)b * 1024 + h * 64 + pb * 32 + r) * 2048 + c * 64 + kk * 16 + 8 * hh);
        bf16* outb = CST + ((size_t)((b * 32 + c) * 16 + h)) * 64 * 128;
#pragma unroll 1
        for (int nb = 0; nb < 4; ++nb) {
            bf16x8 bfr[4];
#pragma unroll
            for (int kk = 0; kk < 4; ++kk) bfr[kk] = ld16(BTR + ((size_t)b * 512 + g * 128 + nb * 32 + r) * 2048 + c * 64 + kk * 16 + 8 * hh);
#pragma unroll
            for (int pb = 0; pb < 2; ++pb) {
                f32x16 acc = zero16();
#pragma unroll
                for (int kk = 0; kk < 4; ++kk) acc = MFMA32(af[pb][kk], bfr[kk], acc);
#pragma unroll
                for (int rg = 0; rg < 16; ++rg) outb[(pb * 32 + crow(rg, hh)) * 128 + nb * 32 + r] = (bf16)f2bf(acc[rg]);
            }
        }
    }
}

__device__ __forceinline__ void phase_ssd2(const Args& a) {
    const float* CS = (const float*)(a.ws + WS_CS); bf16* CST = (bf16*)(a.ws + WS_CST);
    for (int e = obid() * 512 + otid(); e < 4 * 16 * 64 * 32; e += gridDim.x * 512) {
        const int b = e >> 15, h = (e >> 11) & 15, pn = e & 2047;
        float st0 = 0.f, st1 = 0.f, st2 = 0.f, st3 = 0.f;
        u32x2* ptr = (u32x2*)(CST + ((size_t)(b * 32 * 16 + h)) * 8192 + (size_t)pn * 4);
        u32x2 nxt = *ptr;
#pragma unroll 1
        for (int c = 0; c < 32; ++c) {
            const u32x2 cur = nxt;
            if (c + 1 < 32) nxt = *(ptr + (size_t)(c + 1) * 16 * 8192 / 4);
            const float dec = expf(CS[((size_t)b * SEQ + c * 64 + 63) * 16 + h]);
            u32x2 o; o.x = pk2(st0, st1); o.y = pk2(st2, st3);
            *(ptr + (size_t)c * 16 * 8192 / 4) = o;
            st0 = fmaf(st0, dec, __uint_as_float(cur.x << 16)); st1 = fmaf(st1, dec, __uint_as_float(cur.x & 0xffff0000u));
            st2 = fmaf(st2, dec, __uint_as_float(cur.y << 16)); st3 = fmaf(st3, dec, __uint_as_float(cur.y & 0xffff0000u));
        }
    }
}

__device__ __forceinline__ void phase_ssd3(const Args& a, int l, float* smem) {
    const bf16* proj = (const bf16*)(a.ws + WS_PROJ);
    const bf16* XC = (const bf16*)(a.ws + WS_XC); const bf16* XT1 = (const bf16*)(a.ws + WS_XT1); const bf16* PREV = (const bf16*)(a.ws + WS_CST);
    const float* DTS = (const float*)(a.ws + WS_DTS); const float* CS = (const float*)(a.ws + WS_CS);
    float* SSQ = (float*)(a.ws + WS_SSQ); bf16* mix = (bf16*)(a.ws + WS_MIX);
    const int tid = otid(), wave = tid >> 6, lane = tid & 63, r = lane & 31, hh = lane >> 5;
    float* ybuf = smem + wave * 4480;
    float* csl = ybuf + 64 * 68; float* dtl = csl + 64;
    for (int u = obid() * 8 + wave; u < 2048; u += gridDim.x * 8) {
        const int b = u >> 9, c = (u >> 4) & 31, h = u & 15, g = h >> 2;
        const size_t row0 = (size_t)b * SEQ + c * 64;
        csl[lane] = CS[(row0 + lane) * 16 + h]; dtl[lane] = DTS[(row0 + lane) * 16 + h];
        asm volatile("s_waitcnt lgkmcnt(0)" ::: "memory");
        const float Dh = a.in[17][l * 16 + h];
        const bf16* prevb = PREV + ((size_t)((b * 32 + c) * 16 + h)) * 64 * 128;
#pragma unroll 1
        for (int lb = 0; lb < 2; ++lb) {
            bf16x8 cf[8];
#pragma unroll
            for (int kk = 0; kk < 8; ++kk) cf[kk] = ld16(XC + (row0 + lb * 32 + r) * 2048 + 1536 + g * 128 + kk * 16 + 8 * hh);
            f32x16 yo[2]; yo[0] = zero16(); yo[1] = zero16();
#pragma unroll
            for (int pb = 0; pb < 2; ++pb)
#pragma unroll
                for (int kk = 0; kk < 8; ++kk) { const bf16x8 pf = ld16(prevb + (pb * 32 + r) * 128 + kk * 16 + 8 * hh); yo[pb] = MFMA32(pf, cf[kk], yo[pb]); }
            const float csL = csl[lb * 32 + r];
            const float eL = expf(csL);
            f32x16 yd[2]; yd[0] = zero16(); yd[1] = zero16();
#pragma unroll 1
            for (int sb = 0; sb <= lb; ++sb) {
                f32x16 gt = zero16();
#pragma unroll
                for (int kk = 0; kk < 8; ++kk) { const bf16x8 bfm = ld16(XC + (row0 + sb * 32 + r) * 2048 + 1024 + g * 128 + kk * 16 + 8 * hh); gt = MFMA32(bfm, cf[kk], gt); }
                const int lcol = lb * 32 + r;
#pragma unroll
                for (int rg = 0; rg < 16; ++rg) { const int sidx = sb * 32 + crow(rg, hh); const float v = gt[rg] * expf(fminf(csL - csl[sidx], 0.f)) * dtl[sidx]; gt[rg] = (sidx <= lcol) ? v : 0.f; }
#pragma unroll
                for (int s16 = 0; s16 < 2; ++s16) {
                    u32x4 sv; sv.x = pk2(gt[8 * s16 + 0], gt[8 * s16 + 1]); sv.y = pk2(gt[8 * s16 + 2], gt[8 * s16 + 3]); sv.z = pk2(gt[8 * s16 + 4], gt[8 * s16 + 5]); sv.w = pk2(gt[8 * s16 + 6], gt[8 * s16 + 7]);
                    const bf16x8 sf = __builtin_bit_cast(bf16x8, sv);
#pragma unroll
                    for (int pb = 0; pb < 2; ++pb) {
                        const bf16* xp = XT1 + ((size_t)b * 1024 + h * 64 + pb * 32 + r) * 2048 + c * 64 + sb * 32 + 16 * s16 + 4 * hh;
                        const bf16x8 xf = ld8x2(xp, xp + 8);
                        yd[pb] = MFMA32(xf, sf, yd[pb]);
                    }
                }
            }
#pragma unroll
            for (int pb = 0; pb < 2; ++pb)
#pragma unroll
                for (int rg = 0; rg < 16; ++rg) ybuf[(lb * 32 + r) * 68 + pb * 32 + crow(rg, hh)] = yd[pb][rg] + eL * yo[pb][rg];
        }
        asm volatile("s_waitcnt lgkmcnt(0)" ::: "memory");
#pragma unroll 1
        for (int it = 0; it < 8; ++it) {
            const int lrow = it * 8 + (lane >> 3), p8 = (lane & 7) * 8;
            const size_t row = row0 + lrow;
            const float4 y0 = *(const float4*)(ybuf + lrow * 68 + p8), y1 = *(const float4*)(ybuf + lrow * 68 + p8 + 4);
            float x8[8], z8[8];
            unpack8(*(const u32x4*)(XC + row * 2048 + h * 64 + p8), x8);
            unpack8(*(const u32x4*)(proj + row * PP + P_SSDZ + h * 64 + p8), z8);
            const float yy[8] = {y0.x, y0.y, y0.z, y0.w, y1.x, y1.y, y1.z, y1.w};
            float o[8]; float ss = 0.f;
#pragma unroll
            for (int j = 0; j < 8; ++j) { o[j] = (yy[j] + Dh * x8[j]) * siluf(z8[j]); ss = fmaf(o[j], o[j], ss); }
            ss += __shfl_xor(ss, 1); ss += __shfl_xor(ss, 2); ss += __shfl_xor(ss, 4);
            if ((lane & 7) == 0) SSQ[row * 16 + h] = ss;
            u32x4 w; w.x = pk2(o[0], o[1]); w.y = pk2(o[2], o[3]); w.z = pk2(o[4], o[5]); w.w = pk2(o[6], o[7]);
            *(u32x4*)(mix + row * D_MODEL + MX_SSD + h * 64 + p8) = w;
        }
        asm volatile("s_waitcnt lgkmcnt(0)" ::: "memory");
    }
}

__device__ __forceinline__ void phase_ssd_norm(const Args& a, int l) {
    const float* SSQ = (const float*)(a.ws + WS_SSQ);
    bf16* mix = (bf16*)(a.ws + WS_MIX);
    const float* nwp = a.in[18] + (size_t)l * 1024;
    const int tid = otid(), wave = tid >> 6, lane = tid & 63;
    for (int row = obid() * 8 + wave; row < M_TOK; row += gridDim.x * 8) {
        float s = (lane < 16) ? SSQ[(size_t)row * 16 + lane] : 0.f;
        s = wave_sum(s);
        const float rs = 1.0f / sqrtf(s * (1.0f / 1024.f) + EPS);
#pragma unroll
        for (int j = 0; j < 2; ++j) {
            bf16* p = mix + (size_t)row * D_MODEL + MX_SSD + (lane + 64 * j) * 8;
            float v[8]; unpack8(*(const u32x4*)p, v);
            const float4 w0 = *(const float4*)(nwp + (lane + 64 * j) * 8), w1 = *(const float4*)(nwp + (lane + 64 * j) * 8 + 4);
            u32x4 o; o.x = pk2(v[0] * rs * w0.x, v[1] * rs * w0.y); o.y = pk2(v[2] * rs * w0.z, v[3] * rs * w0.w); o.z = pk2(v[4] * rs * w1.x, v[5] * rs * w1.y); o.w = pk2(v[6] * rs * w1.z, v[7] * rs * w1.w);
            *(u32x4*)p = o;
        }
    }
}

__device__ __forceinline__ int t5_bucket(int rel) {
    const int ret = rel > 0 ? 16 : 0; const int n = rel < 0 ? -rel : rel;
    if (n < 8) return ret + n;
    const int e = 31 - __clz(n);
    int v = 8 + 2 * (e - 3) + ((n * n) >= (1 << (2 * e + 1)) ? 1 : 0);
    return ret + (v < 15 ? v : 15);
}

__device__ __forceinline__ void phase_btab(const Args& a) {
    float* bt = (float*)(a.ws + WS_BTAB);
    for (int i = obid() * 512 + otid(); i < 8 * 4096; i += gridDim.x * 512) { const int h = i >> 12, rel = (i & 4095) - 2048; bt[i] = a.in[19][t5_bucket(rel) * 8 + h]; }
}

typedef float f32x4v __attribute__((ext_vector_type(4)));
constexpr int SC_STRIDE = 2052;
__device__ __forceinline__ void dsa_unit(const Args& a, int unit, float* smem) {
    const bf16* proj = (const bf16*)(a.ws + WS_PROJ);
    const float* side = (const float*)(a.ws + WS_SIDE);
    const bf16* VT = (const bf16*)(a.ws + WS_VT);
    const float* BT = (const float*)(a.ws + WS_BTAB);
    bf16* mix = (bf16*)(a.ws + WS_MIX);
    float* sc = smem;
    unsigned long long* msk = (unsigned long long*)(smem + 16 * SC_STRIDE);
    const int tid = otid(), wave = tid >> 6, lane = tid & 63, cc = lane & 15, q4 = lane >> 4;
    const int b = unit >> 7, q16 = unit & 127, c = q16 >> 2, nk = 64 * (c + 1);
    const int tq0 = q16 * 16;
    const size_t rowb = (size_t)b * SEQ, rowq = rowb + tq0;
    __syncthreads();
    {
        bf16x8 aq[8][2]; float wq[4][8];
#pragma unroll
        for (int h = 0; h < 8; ++h)
#pragma unroll
            for (int kk = 0; kk < 2; ++kk) aq[h][kk] = ld16(proj + (rowq + cc) * PP + P_IQ + h * 64 + kk * 32 + 8 * q4);
#pragma unroll
        for (int rg = 0; rg < 4; ++rg) {
            const float4 w0 = *(const float4*)(side + (rowq + q4 * 4 + rg) * 32 + 16), w1 = *(const float4*)(side + (rowq + q4 * 4 + rg) * 32 + 20);
            const float sc_ = 0.044194173824159216f;
            wq[rg][0] = w0.x * sc_; wq[rg][1] = w0.y * sc_; wq[rg][2] = w0.z * sc_; wq[rg][3] = w0.w * sc_; wq[rg][4] = w1.x * sc_; wq[rg][5] = w1.y * sc_; wq[rg][6] = w1.z * sc_; wq[rg][7] = w1.w * sc_;
        }
        const int nkb = 4 * (c + 1);
#pragma unroll 1
        for (int kb = wave; kb < nkb; kb += 8) {
            const int key0 = kb * 16;
            const bf16x8 bk0 = ld16(proj + (rowb + key0 + cc) * PP + P_IK + 8 * q4), bk1 = ld16(proj + (rowb + key0 + cc) * PP + P_IK + 32 + 8 * q4);
            f32x4v s4 = {0.f, 0.f, 0.f, 0.f};
#pragma unroll
            for (int h = 0; h < 8; ++h) {
                f32x4v acc = {0.f, 0.f, 0.f, 0.f};
                acc = MFMA16(aq[h][0], bk0, acc); acc = MFMA16(aq[h][1], bk1, acc);
#pragma unroll
                for (int rg = 0; rg < 4; ++rg) s4[rg] = fmaf(fmaxf(acc[rg], 0.f), wq[rg][h], s4[rg]);
            }
#pragma unroll
            for (int rg = 0; rg < 4; ++rg) sc[(q4 * 4 + rg) * SC_STRIDE + key0 + cc] = s4[rg] + 0.0f;
        }
    }
    __syncthreads();
#pragma unroll 1
    for (int qq = 0; qq < 2; ++qq) {
        const int q = wave * 2 + qq;
        if (nk <= 256) {
            if (lane <= c) msk[q * 32 + lane] = ~0ull;
        } else {
            unsigned key[32];
#pragma unroll
            for (int r = 0; r < 32; ++r) {
                key[r] = 0u;
                if (r <= c) { const unsigned u = __float_as_uint(sc[q * SC_STRIDE + r * 64 + lane]); key[r] = (u & 0x80000000u) ? ~u : (u | 0x80000000u); }
            }
            unsigned T = 0u; bool exact = false;
#pragma unroll 1
            for (int bit = 31; bit >= 0; --bit) {
                const unsigned cand = T | (1u << bit);
                int cnt = 0;
#pragma unroll
                for (int r = 0; r < 32; ++r) if (r <= c) cnt += __popcll(__ballot(key[r] >= cand));
                if (cnt >= 256) T = cand;
                if (cnt == 256) { exact = true; break; }
            }
            if (exact) {
#pragma unroll
                for (int r = 0; r < 32; ++r) if (r <= c) { const unsigned long long m = __ballot(key[r] >= T); if (lane == 0) msk[q * 32 + r] = m; }
            } else {
                int cgt = 0;
#pragma unroll
                for (int r = 0; r < 32; ++r) if (r <= c) cgt += __popcll(__ballot(key[r] > T));
                int need = 256 - cgt;
#pragma unroll
                for (int r = 0; r < 32; ++r) if (r <= c) {
                    const unsigned long long gm = __ballot(key[r] > T); unsigned long long em = __ballot(key[r] == T);
                    const int pc = __popcll(em);
                    if (pc <= need) need -= pc;
                    else { while (__popcll(em) > need) em &= ~(1ull << (63 - __clzll((long long)em))); need = 0; }
                    if (lane == 0) msk[q * 32 + r] = gm | em;
                }
            }
        }
    }
    __syncthreads();
    {
        const int h = wave;
        const bf16x8 bq0 = ld16(proj + (rowq + cc) * PP + P_AQ + h * 64 + 8 * q4), bq1 = ld16(proj + (rowq + cc) * PP + P_AQ + h * 64 + 32 + 8 * q4);
        f32x4v o[4];
#pragma unroll
        for (int dt = 0; dt < 4; ++dt) o[dt] = (f32x4v){0.f, 0.f, 0.f, 0.f};
        float m = -INFINITY, lsum = 0.f;
        const float* bth = BT + h * 4096 + 2048 - (tq0 + cc);
        const bf16* vtb = VT + (size_t)b * 64 * 2048;
        const int nst = 2 * (c + 1);
#pragma unroll 1
        for (int ks = 0; ks < nst; ++ks) {
            const int kbase = ks * 32;
            const bf16* kp0 = proj + (rowb + kbase + cc) * PP + P_AK + 8 * q4;
            const bf16* kp1 = kp0 + (size_t)16 * PP;
            const bf16x8 k00 = ld16(kp0), k01 = ld16(kp0 + 32), k10 = ld16(kp1), k11 = ld16(kp1 + 32);
            f32x4v s0 = {0.f, 0.f, 0.f, 0.f}, s1 = {0.f, 0.f, 0.f, 0.f};
            s0 = MFMA16(k00, bq0, s0); s0 = MFMA16(k01, bq1, s0);
            s1 = MFMA16(k10, bq0, s1); s1 = MFMA16(k11, bq1, s1);
            const unsigned long long mw = msk[cc * 32 + (kbase >> 6)];
            const unsigned bits = (unsigned)(mw >> ((kbase & 63) + q4 * 4));
            float lg[8]; float mx = -INFINITY;
#pragma unroll
            for (int rg = 0; rg < 4; ++rg) {
                const int kpos0 = kbase + q4 * 4 + rg;
                lg[rg] = ((bits >> rg) & 1u) ? fmaf(s0[rg], 0.125f, bth[kpos0]) : -INFINITY;
                lg[4 + rg] = ((bits >> (16 + rg)) & 1u) ? fmaf(s1[rg], 0.125f, bth[kpos0 + 16]) : -INFINITY;
                mx = fmaxf(mx, fmaxf(lg[rg], lg[4 + rg]));
            }
            mx = fmaxf(mx, __shfl_xor(mx, 16)); mx = fmaxf(mx, __shfl_xor(mx, 32));
            const float mn = fmaxf(m, mx);
            const float alpha = (mn == -INFINITY) ? 1.f : __expf(m - mn);
            const float msub = (mn == -INFINITY) ? 0.f : mn;
            float p[8]; float ps = 0.f;
#pragma unroll
            for (int j = 0; j < 8; ++j) { p[j] = __expf(lg[j] - msub); ps += p[j]; }
            lsum = fmaf(lsum, alpha, ps); m = mn;
            u32x4 pv; pv.x = pk2(p[0], p[1]); pv.y = pk2(p[2], p[3]); pv.z = pk2(p[4], p[5]); pv.w = pk2(p[6], p[7]);
            const bf16x8 pf = __builtin_bit_cast(bf16x8, pv);
#pragma unroll
            for (int dt = 0; dt < 4; ++dt) {
                const bf16* vp = vtb + (size_t)(dt * 16 + cc) * 2048 + kbase + 4 * q4;
                const bf16x8 vf = ld8x2(vp, vp + 16);
                o[dt] = o[dt] * alpha;
                o[dt] = MFMA16(vf, pf, o[dt]);
            }
        }
        lsum += __shfl_xor(lsum, 16); lsum += __shfl_xor(lsum, 32);
        const float inv = 1.0f / lsum;
#pragma unroll
        for (int dt = 0; dt < 4; ++dt) {
            const int d0 = dt * 16 + q4 * 4;
            const float4 z = ldbf4(proj + (rowq + cc) * PP + P_AZ + h * 64 + d0);
            u32x2 w; w.x = pk2(o[dt][0] * inv * siluf(z.x), o[dt][1] * inv * siluf(z.y)); w.y = pk2(o[dt][2] * inv * siluf(z.z), o[dt][3] * inv * siluf(z.w));
            *(u32x2*)(mix + (rowq + cc) * D_MODEL + MX_ATT + h * 64 + d0) = w;
        }
    }
}
__device__ __forceinline__ void phase_dsa(const Args& a, int l, float* smem) {
    for (int k = obid(); k < 256; k += gridDim.x) { dsa_unit(a, k, smem); dsa_unit(a, 511 - k, smem); }
}

constexpr int LDS_BYTES = 147456;
__global__ void __launch_bounds__(512, 2) mk_fwd(Args a) {
    extern __shared__ __attribute__((aligned(16))) unsigned char lds[];
    float* smem = (float*)lds;
    cg::grid_group grid = cg::this_grid();
    const int G = gridDim.x;
    bf16* XB = (bf16*)(a.ws + WS_XB); bf16* PROJ = (bf16*)(a.ws + WS_PROJ); bf16* MIX = (bf16*)(a.ws + WS_MIX); bf16* YG = (bf16*)(a.ws + WS_YG);
    phase_prologue(a, smem);
    phase_btab(a);
    grid.sync();
    for (int l = 0; l < DEPTH; ++l) {
        const float* xcur = (l == 0) ? a.in[0] : a.out;
        {
            pg8::Gemm g{XB, (const bf16*)(a.ws + WS_WIN + l * WIN_L), M_TOK, PP, D_MODEL}; pg8::StaticOrder S; S.init(M_TOK, PP, G, obid());
            EpiProj E{PROJ, (float*)(a.ws + WS_SIDE), (bf16*)(a.ws + WS_VT)};
            pg8::gemm_phase<EpiProj, pg8::StaticOrder, true, true>((LAS unsigned char*)lds, g, S, E);
        }
        grid.sync();
        phase_s5(a, l, smem);
        phase_ssd_pre(a, l, smem);
        phase_dsa(a, l, smem);
        grid.sync();
        {
            pg8::Gemm g{YG, (const bf16*)(a.ws + WS_WGLU + l * WGLU_L), M_TOK, 512, 512}; pg8::StaticOrder S; S.init(M_TOK, 512, G, obid());
            EpiGlu E{YG, PROJ, a.in[12] + (size_t)l * 512, MIX};
            pg8::gemm_phase<EpiGlu, pg8::StaticOrder, true, true>((LAS unsigned char*)lds, g, S, E);
        }
        phase_ssd1(a);
        grid.sync();
        phase_ssd2(a);
        grid.sync();
        phase_ssd3(a, l, smem);
        grid.sync();
        phase_ssd_norm(a, l);
        grid.sync();
        {
            pg8::Gemm g{MIX, (const bf16*)(a.ws + WS_WOUT + l * WOUT_L), M_TOK, D_MODEL, D_MODEL}; pg8::StaticOrder S; S.init(M_TOK, D_MODEL, G, obid());
            EpiOut E{xcur, a.out};
            pg8::gemm_phase<EpiOut, pg8::StaticOrder, true, true>((LAS unsigned char*)lds, g, S, E);
        }
        grid.sync();
        if (l + 1 < DEPTH) { phase_rmsnorm_bf16(a.out, a.in[1] + (size_t)(l + 1) * D_MODEL, XB); grid.sync(); }
    }
    phase_rmsnorm_f32(a.out, a.in[21], a.out);
}

extern "C" void kernel_launch(void* const* d_in, const int* in_sizes, int n_in, void* d_out, int out_size, void* d_ws, size_t ws_size, hipStream_t stream) {
    if (n_in != 22 || out_size != M_TOK * D_MODEL || ws_size < WS_END) {
        fprintf(stderr, "kernel_launch: unexpected problem: n_in %d out %d ws %zu\n", n_in, out_size, ws_size);
        return;
    }
    static int grid_blocks = 0;
    if (!grid_blocks) {
        int dev = 0, cus = 0, per_cu = 0;
        (void)hipGetDevice(&dev);
        (void)hipDeviceGetAttribute(&cus, hipDeviceAttributeMultiprocessorCount, dev);
        (void)hipFuncSetAttribute((const void*)mk_fwd, hipFuncAttributeMaxDynamicSharedMemorySize, LDS_BYTES);
        (void)hipOccupancyMaxActiveBlocksPerMultiprocessor(&per_cu, (const void*)mk_fwd, 512, LDS_BYTES);
        if (per_cu < 1) fprintf(stderr, "kernel_launch: occupancy query says %d blocks/CU\n", per_cu);
        grid_blocks = cus;
    }
    Args a{};
    for (int i = 0; i < 22; ++i) a.in[i] = (const float*)d_in[i];
    a.out = (float*)d_out; a.ws = (unsigned char*)d_ws;
    void* args[] = {&a};
    hipError_t e = hipLaunchCooperativeKernel((void*)mk_fwd, dim3(grid_blocks), dim3(512), args, LDS_BYTES, stream);
    if (e != hipSuccess) fprintf(stderr, "cooperative launch failed: %s (grid %d)\n", hipGetErrorString(e), grid_blocks);
}
```

```cpp
#include <hip/hip_runtime.h>
#include <cstdint>
#include <cstdio>
#include <hip/hip_cooperative_groups.h>
namespace cg = cooperative_groups;

__device__ __forceinline__ int otid() { int t = threadIdx.x; asm volatile("" : "+v"(t)); return t; }
__device__ __forceinline__ int obid() { int b = blockIdx.x; asm volatile("" : "+s"(b)); return b; }
namespace pg8 {
#define PG8_LAS __attribute__((address_space(3)))
typedef unsigned short bf16_t;
typedef short bf16x8 __attribute__((ext_vector_type(8)));
typedef float f32x4 __attribute__((ext_vector_type(4)));
typedef unsigned u32x4 __attribute__((ext_vector_type(4)));
constexpr int BM = 256, BK = 64, HALF = 128, HTB = HALF * BK * 2  , STAGE_BYTES = 8 * HTB, NXCD = 8, WGM = 8;

__host__ __device__ __forceinline__ int lds_byte(int r, int c) { const int st = (r >> 4) * 2 + (c >> 5), rr = r & 15, cc = c & 31, ob = rr * 64 + cc * 2; return st * 1024 + (ob ^ (((ob >> 9) & 1) << 5)); }
__host__ __device__ __forceinline__ void stage_rc(int b, int& R, int& C) { const int st = b / 1024, sb = b % 1024, swz = sb ^ (((sb >> 9) & 1) << 5); R = (st >> 1) * 16 + swz / 64; C = (st & 1) * 32 + (swz % 64) / 2; }
__host__ __device__ __forceinline__ int perm32(int rho) { const int n = rho >> 4, i = rho & 15; return 8 * (i >> 2) + 4 * n + (i & 3); }

struct Unit { int pm, pn; };
struct Gemm { const bf16_t* A; const bf16_t* Bt; int M, N, K; };

struct StaticOrder {
    int nM, nN, nwg, G, c;
    __host__ __device__ void init(int M, int N, int G_, int c_) { nM = M / BM; nN = N / BM; nwg = nM * nN; G = G_; c = c_; }
    __host__ __device__ bool next(int i, Unit& u) const {
        const long L = (long)i * G + c; if (L >= nwg) return false;
        int wgid = (int)L; { const int q = nwg / NXCD, r = nwg % NXCD, xcd = wgid % NXCD, off = wgid / NXCD; wgid = (xcd < r ? xcd * (q + 1) : r * (q + 1) + (xcd - r) * q) + off; }
        const int nig = WGM * nN, gid = wgid / nig, fm = gid * WGM, gsz = (nM - fm) < WGM ? (nM - fm) : WGM;
        u.pm = fm + ((wgid % nig) % gsz); u.pn = (wgid % nig) / gsz; return true;
    }
    __device__ __forceinline__ void a_ready(const Unit&) const {}
    __device__ __forceinline__ void done(const Unit&) const {}
};


__device__ __forceinline__ unsigned cvt_pk_bf16(float lo, float hi) { unsigned r; asm volatile("v_cvt_pk_bf16_f32 %0, %1, %2" : "=v"(r) : "v"(lo), "v"(hi)); return r; }
template <class Epi, class Sched, bool ALIGN_EPI = false, bool SP2 = false>
__device__ __forceinline__ void gemm_phase(PG8_LAS unsigned char* lds, const Gemm g, const Sched& S, const Epi& E) {
    const int tid = otid(), wid = __builtin_amdgcn_readfirstlane(tid >> 6), lane = tid & 63, wr = wid >> 2, wc = wid & 3, fr = lane & 15, fq = lane >> 4;
    const int K = g.K, nt = K / BK;
    unsigned voffA[2], voffB[2];
#pragma unroll
    for (int i = 0; i < 2; ++i) { int R, C; stage_rc(tid * 16 + i * 8192, R, C); const int Rb = Epi::PERM ? ((R & ~31) + perm32(R & 31)) : R;
        voffA[i] = (unsigned)(R * K + C) * 2u; voffB[i] = (unsigned)(Rb * K + C) * 2u; }
    const size_t kstep = (size_t)(BK * 2);
    const size_t hstep = (size_t)HALF * K * 2;
    const size_t tstep = 2 * hstep;
    const unsigned ldsw = (unsigned)wid * 1024u;
    const int aoff = lds_byte(wr * 64 + fr, fq * 8), boff = lds_byte(wc * 32 + fr, fq * 8);
#define PG8_SA(b, h) (((b) * 2 + (h)) * HTB)
#define PG8_SB(b, h) ((4 + (b) * 2 + (h)) * HTB)
#define PG8_STAGE(bufoff, gbase, voff) do { _Pragma("unroll") for (int _i = 0; _i < 2; ++_i) \
        __builtin_amdgcn_global_load_lds((const unsigned*)((const char*)(gbase) + (voff)[_i]), (PG8_LAS unsigned*)(lds + (bufoff) + ldsw + _i * 8192), 16, 0, 0); } while (0)
#define PG8_LDA(dst, b, h) do { _Pragma("unroll") for (int m = 0; m < 4; ++m) _Pragma("unroll") for (int k = 0; k < 2; ++k) dst[m][k] = *(const PG8_LAS bf16x8*)(lds + PG8_SA(b, h) + aoff + m * 2048 + k * 1024); } while (0)
#define PG8_LDB(dst, b, h) do { _Pragma("unroll") for (int n = 0; n < 2; ++n) _Pragma("unroll") for (int k = 0; k < 2; ++k) dst[n][k] = *(const PG8_LAS bf16x8*)(lds + PG8_SB(b, h) + boff + n * 2048 + k * 1024); } while (0)
#define PG8_MMA(ai, bj, At, Bt) do { __builtin_amdgcn_s_setprio(1); _Pragma("unroll") for (int m = 0; m < 4; ++m) _Pragma("unroll") for (int n = 0; n < 2; ++n) _Pragma("unroll") for (int k = 0; k < 2; ++k) \
        acc[ai][bj][m][n] = __builtin_amdgcn_mfma_f32_16x16x32_bf16(Bt[n][k], At[m][k], acc[ai][bj][m][n], 0, 0, 0); __builtin_amdgcn_s_setprio(0); } while (0)
#define PG8_WAIT_V(n) asm volatile("s_waitcnt vmcnt(" #n ")" ::: "memory")
#define PG8_WAIT_L(n) asm volatile("s_waitcnt lgkmcnt(" #n ")" ::: "memory")
#define PG8_BAR __builtin_amdgcn_s_barrier()
#define PG8_SCHED __builtin_amdgcn_sched_barrier(0)
    Unit cur, nxt; int ui = 0;
    if (!S.next(0, cur)) return;
    f32x4 acc[2][2][4][2];
#pragma unroll
    for (int a = 0; a < 2; ++a)
#pragma unroll
        for (int b = 0; b < 2; ++b)
#pragma unroll
            for (int m = 0; m < 4; ++m)
#pragma unroll
                for (int n = 0; n < 2; ++n) acc[a][b][m][n] = (f32x4){0.f, 0.f, 0.f, 0.f};
    bf16x8 At[4][2], B0[2][2], B1[2][2];
    const char* cA = (const char*)g.A + (size_t)cur.pm * tstep; const char* cB = (const char*)g.Bt + (size_t)cur.pn * tstep;
    S.a_ready(cur);
    if constexpr (SP2) {
        PG8_STAGE(PG8_SB(0, 0), cB, voffB); PG8_STAGE(PG8_SB(0, 1), cB + hstep, voffB); PG8_STAGE(PG8_SA(0, 0), cA, voffA); PG8_STAGE(PG8_SA(0, 1), cA + hstep, voffA);
        if (wr == 1) PG8_BAR;
        PG8_WAIT_V(2); PG8_BAR;
        PG8_STAGE(PG8_SB(1, 0), cB + kstep, voffB); PG8_STAGE(PG8_SA(1, 0), cA + kstep, voffA); PG8_STAGE(PG8_SB(1, 1), cB + hstep + kstep, voffB);
        PG8_WAIT_V(6); PG8_BAR;
    } else {
        PG8_STAGE(PG8_SB(0, 0), cB, voffB); PG8_STAGE(PG8_SA(0, 0), cA, voffA); PG8_STAGE(PG8_SB(0, 1), cB + hstep, voffB); PG8_STAGE(PG8_SA(0, 1), cA + hstep, voffA);
        if (wr == 1) PG8_BAR;
        PG8_WAIT_V(4); PG8_BAR;
        PG8_STAGE(PG8_SB(1, 0), cB + kstep, voffB); PG8_STAGE(PG8_SA(1, 0), cA + kstep, voffA); PG8_STAGE(PG8_SB(1, 1), cB + hstep + kstep, voffB);
        PG8_WAIT_V(6); PG8_BAR;
    }
    for (;;) {
        const bool has_next = S.next(ui + 1, nxt);
        const char* nA = has_next ? (const char*)g.A + (size_t)nxt.pm * tstep : cA; const char* nB = has_next ? (const char*)g.Bt + (size_t)nxt.pn * tstep : cB;
        for (int t = 0; t < nt; t += 2) {
            const bool last = (t == nt - 2);
            const char* a1 = cA + (size_t)(t + 1) * kstep;
            const char* a2 = last ? nA : cA + (size_t)(t + 2) * kstep; const char* b2 = last ? nB : cB + (size_t)(t + 2) * kstep;
            const char* a3 = a2 + kstep; const char* b3 = b2 + kstep;
            if (last && has_next) S.a_ready(nxt);
            if constexpr (SP2) {
            PG8_LDB(B0, 0, 0); PG8_LDB(B1, 0, 1); PG8_SCHED; PG8_LDA(At, 0, 0); PG8_STAGE(PG8_SA(1, 1), a1 + hstep, voffA);
            PG8_WAIT_V(8); PG8_WAIT_L(0); PG8_BAR; PG8_MMA(0, 0, At, B0); PG8_MMA(0, 1, At, B1); PG8_BAR; PG8_SCHED;
            PG8_LDA(At, 0, 1); PG8_STAGE(PG8_SB(0, 0), b2, voffB); PG8_STAGE(PG8_SB(0, 1), b2 + hstep, voffB); PG8_STAGE(PG8_SA(0, 0), a2, voffA);
            PG8_WAIT_V(8); PG8_WAIT_L(0); PG8_BAR; PG8_MMA(1, 0, At, B0); PG8_MMA(1, 1, At, B1); PG8_BAR; PG8_SCHED;
            PG8_LDB(B0, 1, 0); PG8_LDB(B1, 1, 1); PG8_SCHED; PG8_LDA(At, 1, 0); PG8_STAGE(PG8_SA(0, 1), a2 + hstep, voffA);
            PG8_WAIT_V(8); PG8_WAIT_L(0); PG8_BAR; PG8_MMA(0, 0, At, B0); PG8_MMA(0, 1, At, B1); PG8_BAR; PG8_SCHED;
            PG8_LDA(At, 1, 1); PG8_STAGE(PG8_SB(1, 0), b3, voffB); PG8_STAGE(PG8_SB(1, 1), b3 + hstep, voffB); PG8_STAGE(PG8_SA(1, 0), a3, voffA);
            PG8_WAIT_V(8); PG8_WAIT_L(0); PG8_BAR; PG8_MMA(1, 0, At, B0); PG8_MMA(1, 1, At, B1); PG8_BAR; PG8_SCHED;
            } else {
            PG8_LDB(B0, 0, 0); PG8_SCHED; PG8_LDA(At, 0, 0); PG8_STAGE(PG8_SA(1, 1), a1 + hstep, voffA);
            PG8_WAIT_L(8); PG8_BAR; PG8_WAIT_L(0); PG8_MMA(0, 0, At, B0); PG8_BAR; PG8_SCHED;
            PG8_LDB(B1, 0, 1); PG8_STAGE(PG8_SB(0, 0), b2, voffB);
            PG8_BAR; PG8_WAIT_L(0); PG8_MMA(0, 1, At, B1); PG8_BAR;
            PG8_LDA(At, 0, 1); PG8_STAGE(PG8_SA(0, 0), a2, voffA);
            PG8_BAR; PG8_WAIT_L(0); PG8_MMA(1, 0, At, B0); PG8_BAR; PG8_SCHED;
            PG8_STAGE(PG8_SB(0, 1), b2 + hstep, voffB);
            PG8_WAIT_V(6); PG8_BAR; PG8_MMA(1, 1, At, B1); PG8_BAR;
            PG8_LDB(B0, 1, 0); PG8_SCHED; PG8_LDA(At, 1, 0); PG8_STAGE(PG8_SA(0, 1), a2 + hstep, voffA);
            PG8_WAIT_L(8); PG8_BAR; PG8_WAIT_L(0); PG8_MMA(0, 0, At, B0); PG8_BAR; PG8_SCHED;
            PG8_LDB(B1, 1, 1); PG8_STAGE(PG8_SB(1, 0), b3, voffB);
            PG8_BAR; PG8_WAIT_L(0); PG8_MMA(0, 1, At, B1); PG8_BAR;
            PG8_LDA(At, 1, 1); PG8_STAGE(PG8_SA(1, 0), a3, voffA);
            PG8_BAR; PG8_WAIT_L(0); PG8_MMA(1, 0, At, B0); PG8_BAR; PG8_SCHED;
            PG8_STAGE(PG8_SB(1, 1), b3 + hstep, voffB);
            PG8_WAIT_V(6); PG8_BAR; PG8_MMA(1, 1, At, B1); PG8_BAR;
            }
        }
        if constexpr (ALIGN_EPI) { if (wr == 0) PG8_BAR; }
        if constexpr (!Epi::AFTER_DRAIN) { E(acc, cur, wr, wc, fr, fq); S.done(cur); }
        if (!has_next) break;
#pragma unroll
        for (int a = 0; a < 2; ++a)
#pragma unroll
            for (int b = 0; b < 2; ++b)
#pragma unroll
                for (int m = 0; m < 4; ++m)
#pragma unroll
                    for (int n = 0; n < 2; ++n) acc[a][b][m][n] = (f32x4){0.f, 0.f, 0.f, 0.f};
        cur = nxt; cA = nA; cB = nB; ++ui;
        if constexpr (ALIGN_EPI) { if (wr == 1) PG8_BAR; }
    }
    PG8_WAIT_V(0);
    if constexpr (!ALIGN_EPI) { if (wr == 0) PG8_BAR; }
    PG8_BAR;
    if constexpr (Epi::AFTER_DRAIN) { E.fused(acc, cur, wr, wc, fr, fq, lds, wid, lane); S.done(cur); }
#undef PG8_SA
#undef PG8_SB
#undef PG8_STAGE
#undef PG8_LDA
#undef PG8_LDB
#undef PG8_MMA
#undef PG8_WAIT_V
#undef PG8_WAIT_L
#undef PG8_BAR
#undef PG8_SCHED
}
}

constexpr int D_MODEL = 2048, BATCH = 4, SEQ = 2048, DEPTH = 2;
constexpr int M_TOK = BATCH * SEQ;
constexpr int D_IN = 5848;
constexpr float EPS = 1e-6f;
constexpr int PP = 5888;
constexpr int P_S5U = 0, P_S5Z = 512, P_SSDZ = 1024, P_XBC = 2048, P_AQ = 4096, P_IQ = 4608, P_AZ = 5120, P_AK = 5632, P_AV = 5696, P_IK = 5760, P_DT = 5824, P_IW = 5840;
constexpr int MX_S5 = 0, MX_SSD = 512, MX_ATT = 1536;

typedef unsigned short bf16;
typedef unsigned u32x4 __attribute__((ext_vector_type(4)));
typedef unsigned u32x2 __attribute__((ext_vector_type(2)));
typedef float f32x4 __attribute__((ext_vector_type(4)));
#define LAS __attribute__((address_space(3)))

constexpr size_t MiB = 1u << 20;
constexpr size_t WS_CTL = 0;
constexpr size_t WS_WIN = 2 * MiB;
constexpr size_t WIN_L = (size_t)PP * 2048 * 2;
constexpr size_t WS_WOUT = 48 * MiB;
constexpr size_t WOUT_L = (size_t)2048 * 2048 * 2;
constexpr size_t WS_WGLU = 64 * MiB;
constexpr size_t WGLU_L = (size_t)512 * 512 * 2;
constexpr size_t WS_S5P = 65 * MiB;
constexpr size_t WS_SIDE = 66 * MiB;
constexpr size_t WS_XB = 68 * MiB;
constexpr size_t WS_PROJ = 100 * MiB;
constexpr size_t WS_MIX = 192 * MiB;
constexpr size_t WS_YG = 224 * MiB;
constexpr size_t WS_DTS = 67 * MiB;
constexpr size_t WS_CS = WS_DTS + 512 * 1024;
constexpr size_t WS_XC = 232 * MiB;
constexpr size_t WS_XT1 = 264 * MiB;
constexpr size_t WS_XT2 = 280 * MiB;
constexpr size_t WS_BTR = 296 * MiB;
constexpr size_t WS_CST = 304 * MiB;
constexpr size_t WS_SSQ = 336 * MiB;
constexpr size_t WS_BTAB = 336 * MiB + 512 * 1024;
constexpr size_t WS_VF = 337 * MiB;
constexpr size_t WS_KF = 338 * MiB;
constexpr size_t WS_IKF = 339 * MiB;
constexpr size_t WS_END = 340 * MiB;
static_assert(WS_WIN + 2 * WIN_L <= WS_WOUT && WS_WOUT + 2 * WOUT_L <= WS_WGLU, "ws map");

struct Args {
    const float* in[22];
    float* out;
    unsigned char* ws;
};

__device__ __forceinline__ float bf2f(unsigned v) { return __uint_as_float(v << 16); }
__device__ __forceinline__ unsigned f2bf(float f) { unsigned u = __float_as_uint(f); return (u + 0x7fffu + ((u >> 16) & 1u)) >> 16; }
__device__ __forceinline__ unsigned pk2(float lo, float hi) { return f2bf(lo) | (f2bf(hi) << 16); }
__device__ __forceinline__ float4 ldbf4(const bf16* p) { const u32x2 u = *(const u32x2*)p; float4 r; r.x = __uint_as_float(u.x << 16); r.y = __uint_as_float(u.x & 0xffff0000u); r.z = __uint_as_float(u.y << 16); r.w = __uint_as_float(u.y & 0xffff0000u); return r; }
__device__ __forceinline__ void unpack8(const u32x4 u, float* f) {
    f[0] = __uint_as_float(u.x << 16); f[1] = __uint_as_float(u.x & 0xffff0000u); f[2] = __uint_as_float(u.y << 16); f[3] = __uint_as_float(u.y & 0xffff0000u);
    f[4] = __uint_as_float(u.z << 16); f[5] = __uint_as_float(u.z & 0xffff0000u); f[6] = __uint_as_float(u.w << 16); f[7] = __uint_as_float(u.w & 0xffff0000u);
}

__device__ __forceinline__ float wave_sum(float v) {
#pragma unroll
    for (int o = 1; o < 64; o <<= 1) v += __shfl_xor(v, o);
    return v;
}
__device__ __forceinline__ float wave_max(float v) {
#pragma unroll
    for (int o = 1; o < 64; o <<= 1) v = fmaxf(v, __shfl_xor(v, o));
    return v;
}
__device__ __forceinline__ float siluf(float x) { return x / (1.0f + expf(-x)); }
__device__ __forceinline__ float sigmoidf_(float x) { return 1.0f / (1.0f + expf(-x)); }
__device__ __forceinline__ float gelu_tanh(float x) { return 0.5f * x * (1.0f + tanhf(0.7978845608028654f * (x + 0.044715f * x * x * x))); }
__device__ __forceinline__ float softplusf_(float x) { return fmaxf(x, 0.f) + log1pf(expf(-fabsf(x))); }

struct EpiProj {
    static constexpr bool PERM = true, AFTER_DRAIN = false;
    bf16* P; float* side; bf16* VF; bf16* KF; bf16* IKF;
    __device__ __forceinline__ void operator()(const pg8::f32x4 (&acc)[2][2][4][2], const pg8::Unit& u, int wr, int wc, int fr, int fq) const {
        const int row0 = u.pm * 256 + wr * 64 + fr, col0 = u.pn * 256 + wc * 32 + 8 * fq;
        const bool last = (u.pn == 22);
        const bool sidew = last && (wc == 2) && (fq < 3);
#pragma unroll
        for (int ai = 0; ai < 2; ++ai)
#pragma unroll
            for (int m = 0; m < 4; ++m) {
                const int row = row0 + ai * 128 + m * 16;
                bf16* rowp = P + (size_t)row * PP + col0;
                const int bb = row >> 11, t = row & 2047;
#pragma unroll
                for (int bj = 0; bj < 2; ++bj) {
                    const pg8::f32x4 v0 = acc[ai][bj][m][0], v1 = acc[ai][bj][m][1];
                    u32x4 w; w.x = pg8::cvt_pk_bf16(v0[0], v0[1]); w.y = pg8::cvt_pk_bf16(v0[2], v0[3]); w.z = pg8::cvt_pk_bf16(v1[0], v1[1]); w.w = pg8::cvt_pk_bf16(v1[2], v1[3]);
                    *(u32x4*)(rowp + bj * 128) = w;
                    if (last) {
                        if (bj == 1 && sidew) { float* sp = side + (size_t)row * 32 + 8 * fq; *(pg8::f32x4*)sp = v0; *(pg8::f32x4*)(sp + 4) = v1; }
                        if (wc < 2) {
                            if (bj == 0) *(u32x4*)(KF + ((((size_t)(bb * 64 + (t >> 5)) * 2 + ((t >> 4) & 1)) * 2 + wc) * 64 + fq * 16 + (t & 15)) * 8) = w;
                            else *(u32x4*)(IKF + (((size_t)(bb * 128 + (t >> 4)) * 2 + wc) * 64 + fq * 16 + (t & 15)) * 8) = w;
                        } else if (bj == 0) {
                            const int kk32 = t & 31;
                            bf16* vp = VF + ((((size_t)(bb * 64 + (t >> 5)) * 4 + (wc - 2) * 2 + (fq >> 1)) * 64 + ((kk32 & 15) >> 2) * 16 + 8 * (fq & 1)) * 8) + (kk32 >> 4) * 4 + (kk32 & 3);
#pragma unroll
                            for (int e = 0; e < 4; ++e) { vp[e * 8] = (bf16)f2bf(v0[e]); vp[(4 + e) * 8] = (bf16)f2bf(v1[e]); }
                        }
                    }
                }
            }
    }
};
struct EpiOut {
    static constexpr bool PERM = false, AFTER_DRAIN = false;
    const float* base; float* out;
    __device__ __forceinline__ void operator()(const pg8::f32x4 (&acc)[2][2][4][2], const pg8::Unit& u, int wr, int wc, int fr, int fq) const {
        const int col0 = u.pn * 256 + wc * 32 + 4 * fq;
#pragma unroll
        for (int ai = 0; ai < 2; ++ai)
#pragma unroll
            for (int m = 0; m < 4; ++m) {
                const int r = u.pm * 256 + ai * 128 + wr * 64 + m * 16 + fr; const size_t off = (size_t)r * D_MODEL + col0;
#pragma unroll
                for (int bj = 0; bj < 2; ++bj)
#pragma unroll
                    for (int n = 0; n < 2; ++n) { const pg8::f32x4 bs = *(const pg8::f32x4*)(base + off + bj * 128 + n * 16); *(pg8::f32x4*)(out + off + bj * 128 + n * 16) = bs + acc[ai][bj][m][n]; }
            }
    }
};
struct EpiGlu {
    static constexpr bool PERM = true, AFTER_DRAIN = false;
    const bf16* yg; const bf16* proj; const float* gb; bf16* mix;
    __device__ __forceinline__ void operator()(const pg8::f32x4 (&acc)[2][2][4][2], const pg8::Unit& u, int wr, int wc, int fr, int fq) const {
        const int row0 = u.pm * 256 + wr * 64 + fr, col0 = u.pn * 256 + wc * 32 + 8 * fq;
#pragma unroll
        for (int ai = 0; ai < 2; ++ai)
#pragma unroll
            for (int m = 0; m < 4; ++m) {
                const int row = row0 + ai * 128 + m * 16;
#pragma unroll
                for (int bj = 0; bj < 2; ++bj) {
                    const int c = col0 + bj * 128;
                    float y[8], z[8], o[8];
                    unpack8(*(const u32x4*)(yg + (size_t)row * 512 + c), y);
                    unpack8(*(const u32x4*)(proj + (size_t)row * PP + P_S5Z + c), z);
                    const pg8::f32x4 b0 = *(const pg8::f32x4*)(gb + c), b1 = *(const pg8::f32x4*)(gb + c + 4);
                    const pg8::f32x4 v0 = acc[ai][bj][m][0] + b0, v1 = acc[ai][bj][m][1] + b1;
#pragma unroll
                    for (int j = 0; j < 4; ++j) { o[j] = y[j] * sigmoidf_(v0[j]) * siluf(z[j]); o[4 + j] = y[4 + j] * sigmoidf_(v1[j]) * siluf(z[4 + j]); }
                    u32x4 w; w.x = pk2(o[0], o[1]); w.y = pk2(o[2], o[3]); w.z = pk2(o[4], o[5]); w.w = pk2(o[6], o[7]);
                    *(u32x4*)(mix + (size_t)row * D_MODEL + MX_S5 + c) = w;
                }
            }
    }
};

__device__ __forceinline__ int win_src_col(int n) {
    if (n < 4096) return n;
    if (n < 4608) return n - 4096 + 4112;
    if (n < 5120) return n - 4608 + 4752;
    if (n < 5632) return n - 5120 + 5336;
    if (n < 5696) return n - 5632 + 4624;
    if (n < 5760) return n - 5696 + 4688;
    if (n < 5824) return n - 5760 + 5264;
    if (n < 5840) return n - 5824 + 4096;
    if (n < 5848) return n - 5840 + 5328;
    return -1;
}
template <int MODE>
__device__ __forceinline__ void transpose_item(const float* W, int K, int Nsrc, bf16* WT, float* scr, int kb, int nb, int lane) {
    const int k0 = 64 * kb, n0 = 32 * nb;
    const int nsrc = (MODE == 1) ? win_src_col(n0 + (lane & 31)) : (n0 + (lane & 31));
#pragma unroll 8
    for (int i = 0; i < 32; ++i) { const int kk = 2 * i + (lane >> 5); scr[kk * 33 + (lane & 31)] = (nsrc >= 0) ? W[(size_t)(k0 + kk) * Nsrc + nsrc] : 0.f; }
    asm volatile("s_waitcnt lgkmcnt(0)" ::: "memory");
    const int c = lane & 7;
#pragma unroll
    for (int j = 0; j < 4; ++j) { const int n = (lane >> 3) + 8 * j; const float* s = scr + (8 * c) * 33 + n;
        u32x4 o; o.x = pk2(s[0 * 33], s[1 * 33]); o.y = pk2(s[2 * 33], s[3 * 33]); o.z = pk2(s[4 * 33], s[5 * 33]); o.w = pk2(s[6 * 33], s[7 * 33]);
        *(u32x4*)(WT + (size_t)(n0 + n) * K + k0 + 8 * c) = o; }
    asm volatile("s_waitcnt lgkmcnt(0)" ::: "memory");
}

constexpr size_t S5P_LAM = 0, S5P_BBT = 64 * 1024, S5P_CT = 64 * 1024 + 256 * 1024;
__device__ __forceinline__ void phase_s5_params(const Args& a) {
    float* lam = (float*)(a.ws + WS_S5P + S5P_LAM);
    bf16* BBT = (bf16*)(a.ws + WS_S5P + S5P_BBT);
    bf16* CT = (bf16*)(a.ws + WS_S5P + S5P_CT);
    const int gt = obid() * 512 + otid();
    if (gt >= 2 * 32 * 64) return;
    const int l = gt / 2048, g = (gt / 64) % 32, p = gt % 64;
    const float A_re = a.in[3][gt], A_im = a.in[4][gt];
    const float dt = expf(a.in[5][l * 32 + g]);
    const float lre = fminf(A_re, -1e-4f), lim = A_im;
    const float mag = expf(lre * dt);
    const float lbr = mag * cosf(lim * dt), lbi = mag * sinf(lim * dt);
    const float nr = lbr - 1.0f, ni = lbi;
    const float den = lre * lre + lim * lim;
    const float fr = (nr * lre + ni * lim) / den, fi = (ni * lre - nr * lim) / den;
    lam[gt * 2] = lbr; lam[gt * 2 + 1] = lbi;
    for (int c = 0; c < 16; ++c) {
        const float Bre = a.in[6][gt * 16 + c], Bim = a.in[7][gt * 16 + c];
        BBT[((size_t)(l * 32 + g) * 128 + p) * 16 + c] = (bf16)f2bf(fr * Bre - fi * Bim);
        BBT[((size_t)(l * 32 + g) * 128 + 64 + p) * 16 + c] = (bf16)f2bf(fr * Bim + fi * Bre);
        CT[((size_t)(l * 32 + g) * 16 + c) * 128 + p] = (bf16)f2bf(a.in[8][((size_t)(l * 32 + g) * 16 + c) * 64 + p]);
        CT[((size_t)(l * 32 + g) * 16 + c) * 128 + 64 + p] = (bf16)f2bf(-a.in[9][((size_t)(l * 32 + g) * 16 + c) * 64 + p]);
    }
}

__device__ __forceinline__ void phase_rmsnorm_bf16(const float* X, const float* w, bf16* XB) {
    const int wave = otid() >> 6, lane = otid() & 63;
    const int nw = blockDim.x >> 6;
    for (int row = obid() * nw + wave; row < M_TOK; row += gridDim.x * nw) {
        const float4* xr = (const float4*)(X + (size_t)row * D_MODEL);
        float4 v[8]; float s = 0.f;
#pragma unroll
        for (int j = 0; j < 8; ++j) { v[j] = xr[lane + 64 * j]; s += v[j].x * v[j].x + v[j].y * v[j].y + v[j].z * v[j].z + v[j].w * v[j].w; }
        s = wave_sum(s);
        const float rs = 1.0f / sqrtf(s * (1.0f / D_MODEL) + EPS);
        u32x2* hr = (u32x2*)(XB + (size_t)row * D_MODEL);
#pragma unroll
        for (int j = 0; j < 8; ++j) { const float4 ww = ((const float4*)w)[lane + 64 * j];
            u32x2 o; o.x = pk2(v[j].x * rs * ww.x, v[j].y * rs * ww.y); o.y = pk2(v[j].z * rs * ww.z, v[j].w * rs * ww.w); hr[lane + 64 * j] = o; }
    }
}
__device__ __forceinline__ void phase_rmsnorm_f32(const float* X, const float* w, float* H) {
    const int wave = otid() >> 6, lane = otid() & 63;
    const int nw = blockDim.x >> 6;
    for (int row = obid() * nw + wave; row < M_TOK; row += gridDim.x * nw) {
        const float4* xr = (const float4*)(X + (size_t)row * D_MODEL);
        float4 v[8]; float s = 0.f;
#pragma unroll
        for (int j = 0; j < 8; ++j) { v[j] = xr[lane + 64 * j]; s += v[j].x * v[j].x + v[j].y * v[j].y + v[j].z * v[j].z + v[j].w * v[j].w; }
        s = wave_sum(s);
        const float rs = 1.0f / sqrtf(s * (1.0f / D_MODEL) + EPS);
        float4* hr = (float4*)(H + (size_t)row * D_MODEL);
#pragma unroll
        for (int j = 0; j < 8; ++j) { const float4 ww = ((const float4*)w)[lane + 64 * j];
            float4 o; o.x = v[j].x * rs * ww.x; o.y = v[j].y * rs * ww.y; o.z = v[j].z * rs * ww.z; o.w = v[j].w * rs * ww.w; hr[lane + 64 * j] = o; }
    }
}

__device__ __forceinline__ void phase_prologue(const Args& a, float* smem) {
    const int wave = otid() >> 6, lane = otid() & 63;
    float* scr = smem + wave * 4096;
    const int gw = obid() * 8 + wave, NGW = gridDim.x * 8;
    constexpr int I_IN = 32 * (PP / 32), I_OUT = 32 * 64, I_GLU = 8 * 16;
    constexpr int NIT = 2 * (I_IN + I_OUT + I_GLU);
    for (int it = gw; it < NIT; it += NGW) {
        int r = it; const int l = r / (I_IN + I_OUT + I_GLU); r -= l * (I_IN + I_OUT + I_GLU);
        if (r < I_IN) { transpose_item<1>(a.in[2] + (size_t)l * D_MODEL * D_IN, 2048, D_IN, (bf16*)(a.ws + WS_WIN + l * WIN_L), scr, r / (PP / 32), r % (PP / 32), lane); continue; }
        r -= I_IN;
        if (r < I_OUT) { transpose_item<0>(a.in[20] + (size_t)l * D_MODEL * D_MODEL, 2048, 2048, (bf16*)(a.ws + WS_WOUT + l * WOUT_L), scr, r / 64, r % 64, lane); continue; }
        r -= I_OUT;
        transpose_item<0>(a.in[11] + (size_t)l * 512 * 512, 512, 512, (bf16*)(a.ws + WS_WGLU + l * WGLU_L), scr, r / 16, r % 16, lane);
    }
    phase_s5_params(a);
    phase_rmsnorm_bf16(a.in[0], a.in[1], (bf16*)(a.ws + WS_XB));
}

typedef short bf16x8 __attribute__((ext_vector_type(8)));
typedef float f32x16 __attribute__((ext_vector_type(16)));
#define MFMA32(a, b, c) __builtin_amdgcn_mfma_f32_32x32x16_bf16((a), (b), (c), 0, 0, 0)
#define MFMA16(a, b, c) __builtin_amdgcn_mfma_f32_16x16x32_bf16((a), (b), (c), 0, 0, 0)
__device__ __forceinline__ int crow(int r, int hh) { return (r & 3) + 8 * (r >> 2) + 4 * hh; }
__device__ __forceinline__ bf16x8 ld16(const bf16* p) { return *(const bf16x8*)p; }
__device__ __forceinline__ bf16x8 ld8x2(const bf16* p0, const bf16* p1) { const u32x2 x = *(const u32x2*)p0, y = *(const u32x2*)p1; const u32x4 v = {x.x, x.y, y.x, y.y}; return __builtin_bit_cast(bf16x8, v); }
__device__ __forceinline__ f32x16 zero16() { f32x16 z;
#pragma unroll
    for (int i = 0; i < 16; ++i) z[i] = 0.f; return z; }

template <bool OUT>
__device__ __forceinline__ void s5_tile(const bf16* proj, bf16* yg, float* T, size_t row0, int g, int lane, const bf16x8 (&bb)[4], const bf16x8 (&ct)[4], float ar, float ai, float dd, float& xr, float& xi) {
    const int r = lane & 31, hh = lane >> 5, cc = lane & 15, q4 = lane >> 4;
    const bf16x8 uf = ld16(proj + (row0 + r) * PP + P_S5U + g * 16 + 8 * hh);
#pragma unroll
    for (int nb = 0; nb < 4; ++nb) {
        const f32x16 acc = MFMA32(uf, bb[nb], zero16());
#pragma unroll
        for (int rg = 0; rg < 16; ++rg) T[crow(rg, hh) * 132 + nb * 32 + r] = acc[rg];
    }
    asm volatile("s_waitcnt lgkmcnt(0)" ::: "memory");
#pragma unroll 8
    for (int t = 0; t < 32; ++t) {
        const float bur = T[t * 132 + lane], bui = T[t * 132 + 64 + lane];
        const float nxr = fmaf(ar, xr, fmaf(-ai, xi, bur));
        const float nxi = fmaf(ar, xi, fmaf(ai, xr, bui));
        xr = nxr; xi = nxi;
        if (OUT) { T[t * 132 + lane] = xr; T[t * 132 + 64 + lane] = xi; }
    }
    if (OUT) {
        asm volatile("s_waitcnt lgkmcnt(0)" ::: "memory");
#pragma unroll
        for (int mt = 0; mt < 2; ++mt) {
            f32x4 y = {0.f, 0.f, 0.f, 0.f};
#pragma unroll
            for (int kk = 0; kk < 4; ++kk) {
                const float* tp = T + (mt * 16 + cc) * 132 + kk * 32 + 8 * q4;
                const float4 f0 = *(const float4*)tp, f1 = *(const float4*)(tp + 4);
                u32x4 av; av.x = pk2(f0.x, f0.y); av.y = pk2(f0.z, f0.w); av.z = pk2(f1.x, f1.y); av.w = pk2(f1.z, f1.w);
                y = MFMA16(__builtin_bit_cast(bf16x8, av), ct[kk], y);
            }
#pragma unroll
            for (int rg = 0; rg < 4; ++rg) {
                const size_t row = row0 + mt * 16 + q4 * 4 + rg;
                const float ul = bf2f(proj[row * PP + P_S5U + g * 16 + cc]);
                yg[row * 512 + g * 16 + cc] = (bf16)f2bf(gelu_tanh(y[rg] + dd * ul));
            }
        }
    }
    asm volatile("s_waitcnt lgkmcnt(0)" ::: "memory");
}

__device__ __forceinline__ void phase_s5(const Args& a, int l, float* smem) {
    const bf16* proj = (const bf16*)(a.ws + WS_PROJ);
    bf16* yg = (bf16*)(a.ws + WS_YG);
    const float* lam = (const float*)(a.ws + WS_S5P + S5P_LAM) + (size_t)l * 32 * 64 * 2;
    const bf16* BBT = (const bf16*)(a.ws + WS_S5P + S5P_BBT) + (size_t)l * 32 * 128 * 16;
    const bf16* CT = (const bf16*)(a.ws + WS_S5P + S5P_CT) + (size_t)l * 32 * 16 * 128;
    const float* Dp = a.in[10] + (size_t)l * 512;
    const int tid = otid(), wave = tid >> 6, lane = tid & 63, r = lane & 31, hh = lane >> 5, cc = lane & 15, q4 = lane >> 4;
    float* T = smem + wave * 4224;
    float* segend = smem + 8 * 4224;
    for (int unit = obid(); unit < BATCH * 32; unit += gridDim.x) {
        const int b = unit >> 5, g = unit & 31;
        const float ar = lam[(g * 64 + lane) * 2], ai = lam[(g * 64 + lane) * 2 + 1];
        bf16x8 bb[4], ct[4];
#pragma unroll
        for (int nb = 0; nb < 4; ++nb) bb[nb] = ld16(BBT + ((size_t)(g * 128 + nb * 32 + r)) * 16 + 8 * hh);
#pragma unroll
        for (int kk = 0; kk < 4; ++kk) ct[kk] = ld16(CT + ((size_t)(g * 16 + cc)) * 128 + kk * 32 + 8 * q4);
        const float dd = Dp[g * 16 + cc];
        __syncthreads();
        float xr = 0.f, xi = 0.f;
        const size_t rowb = (size_t)b * SEQ + wave * 256;
#pragma unroll 1
        for (int tile = 0; tile < 8; ++tile) s5_tile<false>(proj, yg, T, rowb + tile * 32, g, lane, bb, ct, ar, ai, dd, xr, xi);
        segend[wave * 128 + lane] = xr; segend[wave * 128 + 64 + lane] = xi;
        __syncthreads();
        float pr = ar, pi = ai;
#pragma unroll
        for (int i = 0; i < 8; ++i) { const float t = pr * pr - pi * pi; pi = 2.f * pr * pi; pr = t; }
        float cr = 0.f, ci = 0.f;
        for (int w2 = 0; w2 < wave; ++w2) { const float sr = segend[w2 * 128 + lane], si = segend[w2 * 128 + 64 + lane]; const float t = pr * cr - pi * ci + sr; ci = pr * ci + pi * cr + si; cr = t; }
        xr = cr; xi = ci;
#pragma unroll 1
        for (int tile = 0; tile < 8; ++tile) s5_tile<true>(proj, yg, T, rowb + tile * 32, g, lane, bb, ct, ar, ai, dd, xr, xi);
    }
}


__device__ __forceinline__ void phase_ssd_pre(const Args& a, int l, float* smem) {
    const bf16* proj = (const bf16*)(a.ws + WS_PROJ);
    const float* side = (const float*)(a.ws + WS_SIDE);
    float* DTS = (float*)(a.ws + WS_DTS); float* CS = (float*)(a.ws + WS_CS);
    bf16* XC = (bf16*)(a.ws + WS_XC); bf16* XT1 = (bf16*)(a.ws + WS_XT1); bf16* XT2 = (bf16*)(a.ws + WS_XT2); bf16* BTR = (bf16*)(a.ws + WS_BTR);
    const float* cw = a.in[13] + (size_t)l * 4 * 2048;
    const float* cb = a.in[14] + (size_t)l * 2048;
    float* dtl = smem; float* csl = smem + 1024;
    const int tid = otid(), wave = tid >> 6, lane = tid & 63;
    for (int u = obid(); u < 512; u += gridDim.x) {
        const int b = u >> 7, c = (u >> 2) & 31, q = u & 3;
        const size_t row0 = (size_t)b * SEQ + c * 64;
        __syncthreads();
#pragma unroll
        for (int k = 0; k < 2; ++k) {
            const int h = wave * 2 + k;
            const float dtv = softplusf_(side[(row0 + lane) * 32 + h] + a.in[15][l * 16 + h]);
            float v = dtv * (-expf(a.in[16][l * 16 + h]));
#pragma unroll
            for (int o = 1; o < 64; o <<= 1) { const float t = __shfl_up(v, o); if (lane >= o) v += t; }
            dtl[lane * 16 + h] = dtv; csl[lane * 16 + h] = v;
            if (q == 0) { DTS[(row0 + lane) * 16 + h] = dtv; CS[(row0 + lane) * 16 + h] = v; }
        }
        __syncthreads();
        const int cp = tid & 255, th = tid >> 8, ch = q * 512 + 2 * cp;
        float w0[4], w1[4];
#pragma unroll
        for (int k = 0; k < 4; ++k) { w0[k] = cw[k * 2048 + ch]; w1[k] = cw[k * 2048 + ch + 1]; }
        const float b0 = cb[ch], b1 = cb[ch + 1];
        const bf16* pcol = proj + P_XBC + ch;
        float xa[11], xb[11];
#pragma unroll
        for (int i = 0; i < 3; ++i) {
            const int t = th * 32 - 3 + i;
            unsigned v = 0u; if (c * 64 + t >= 0) v = *(const unsigned*)(pcol + (row0 + t) * PP);
            xa[i] = __uint_as_float(v << 16); xb[i] = __uint_as_float(v & 0xffff0000u);
        }
        const int hx = ch >> 6;
#pragma unroll 1
        for (int grp = 0; grp < 4; ++grp) {
            const int t0 = th * 32 + grp * 8;
#pragma unroll
            for (int i = 0; i < 8; ++i) { const unsigned v = *(const unsigned*)(pcol + (row0 + t0 + i) * PP); xa[3 + i] = __uint_as_float(v << 16); xb[3 + i] = __uint_as_float(v & 0xffff0000u); }
            float ya[8], yb[8];
#pragma unroll
            for (int i = 0; i < 8; ++i) {
                float s0 = b0, s1 = b1;
#pragma unroll
                for (int k = 0; k < 4; ++k) { s0 = fmaf(w0[k], xa[i + k], s0); s1 = fmaf(w1[k], xb[i + k], s1); }
                ya[i] = siluf(s0); yb[i] = siluf(s1);
                *(unsigned*)(XC + (row0 + t0 + i) * 2048 + ch) = pk2(ya[i], yb[i]);
            }
            if (q < 2) {
                bf16* d1 = XT1 + ((size_t)b * 1024 + ch) * 2048 + c * 64 + t0;
                bf16* d2 = XT2 + ((size_t)b * 1024 + ch) * 2048 + c * 64 + t0;
                u32x4 o; o.x = pk2(ya[0], ya[1]); o.y = pk2(ya[2], ya[3]); o.z = pk2(ya[4], ya[5]); o.w = pk2(ya[6], ya[7]); *(u32x4*)d1 = o;
                o.x = pk2(yb[0], yb[1]); o.y = pk2(yb[2], yb[3]); o.z = pk2(yb[4], yb[5]); o.w = pk2(yb[6], yb[7]); *(u32x4*)(d1 + 2048) = o;
                float wg[8]; const float cend = csl[63 * 16 + hx];
#pragma unroll
                for (int i = 0; i < 8; ++i) wg[i] = dtl[(t0 + i) * 16 + hx] * expf(cend - csl[(t0 + i) * 16 + hx]);
                o.x = pk2(ya[0] * wg[0], ya[1] * wg[1]); o.y = pk2(ya[2] * wg[2], ya[3] * wg[3]); o.z = pk2(ya[4] * wg[4], ya[5] * wg[5]); o.w = pk2(ya[6] * wg[6], ya[7] * wg[7]); *(u32x4*)d2 = o;
                o.x = pk2(yb[0] * wg[0], yb[1] * wg[1]); o.y = pk2(yb[2] * wg[2], yb[3] * wg[3]); o.z = pk2(yb[4] * wg[4], yb[5] * wg[5]); o.w = pk2(yb[6] * wg[6], yb[7] * wg[7]); *(u32x4*)(d2 + 2048) = o;
            } else if (q == 2) {
                bf16* d1 = BTR + ((size_t)b * 512 + (ch - 1024)) * 2048 + c * 64 + t0;
                u32x4 o; o.x = pk2(ya[0], ya[1]); o.y = pk2(ya[2], ya[3]); o.z = pk2(ya[4], ya[5]); o.w = pk2(ya[6], ya[7]); *(u32x4*)d1 = o;
                o.x = pk2(yb[0], yb[1]); o.y = pk2(yb[2], yb[3]); o.z = pk2(yb[4], yb[5]); o.w = pk2(yb[6], yb[7]); *(u32x4*)(d1 + 2048) = o;
            }
#pragma unroll
            for (int i = 0; i < 3; ++i) { xa[i] = xa[8 + i]; xb[i] = xb[8 + i]; }
        }
    }
}

__device__ __forceinline__ void phase_ssd1(const Args& a) {
    const bf16* XT2 = (const bf16*)(a.ws + WS_XT2); const bf16* BTR = (const bf16*)(a.ws + WS_BTR); bf16* CST = (bf16*)(a.ws + WS_CST);
    const int tid = otid(), wave = tid >> 6, lane = tid & 63, r = lane & 31, hh = lane >> 5;
    for (int u = obid() * 8 + wave; u < 2048; u += gridDim.x * 8) {
        const int b = u >> 9, c = (u >> 4) & 31, h = u & 15, g = h >> 2;
        bf16x8 af[2][4];
#pragma unroll
        for (int pb = 0; pb < 2; ++pb)
#pragma unroll
            for (int kk = 0; kk < 4; ++kk) af[pb][kk] = ld16(XT2 + ((size_t)b * 1024 + h * 64 + pb * 32 + r) * 2048 + c * 64 + kk * 16 + 8 * hh);
        bf16* outb = CST + ((size_t)((b * 32 + c) * 16 + h)) * 64 * 128;
#pragma unroll 1
        for (int nb = 0; nb < 4; ++nb) {
            bf16x8 bfr[4];
#pragma unroll
            for (int kk = 0; kk < 4; ++kk) bfr[kk] = ld16(BTR + ((size_t)b * 512 + g * 128 + nb * 32 + r) * 2048 + c * 64 + kk * 16 + 8 * hh);
#pragma unroll
            for (int pb = 0; pb < 2; ++pb) {
                f32x16 acc = zero16();
#pragma unroll
                for (int kk = 0; kk < 4; ++kk) acc = MFMA32(af[pb][kk], bfr[kk], acc);
#pragma unroll
                for (int rg = 0; rg < 16; ++rg) outb[(pb * 32 + crow(rg, hh)) * 128 + nb * 32 + r] = (bf16)f2bf(acc[rg]);
            }
        }
    }
}

__device__ __forceinline__ void phase_ssd2(const Args& a) {
    const float* CS = (const float*)(a.ws + WS_CS); bf16* CST = (bf16*)(a.ws + WS_CST);
    for (int e = obid() * 512 + otid(); e < 4 * 16 * 64 * 32; e += gridDim.x * 512) {
        const int b = e >> 15, h = (e >> 11) & 15, pn = e & 2047;
        float st0 = 0.f, st1 = 0.f, st2 = 0.f, st3 = 0.f;
        u32x2* ptr = (u32x2*)(CST + ((size_t)(b * 32 * 16 + h)) * 8192 + (size_t)pn * 4);
        u32x2 nxt = *ptr;
#pragma unroll 1
        for (int c = 0; c < 32; ++c) {
            const u32x2 cur = nxt;
            if (c + 1 < 32) nxt = *(ptr + (size_t)(c + 1) * 16 * 8192 / 4);
            const float dec = expf(CS[((size_t)b * SEQ + c * 64 + 63) * 16 + h]);
            u32x2 o; o.x = pk2(st0, st1); o.y = pk2(st2, st3);
            *(ptr + (size_t)c * 16 * 8192 / 4) = o;
            st0 = fmaf(st0, dec, __uint_as_float(cur.x << 16)); st1 = fmaf(st1, dec, __uint_as_float(cur.x & 0xffff0000u));
            st2 = fmaf(st2, dec, __uint_as_float(cur.y << 16)); st3 = fmaf(st3, dec, __uint_as_float(cur.y & 0xffff0000u));
        }
    }
}

__device__ __forceinline__ void phase_ssd3(const Args& a, int l, float* smem) {
    const bf16* proj = (const bf16*)(a.ws + WS_PROJ);
    const bf16* XC = (const bf16*)(a.ws + WS_XC); const bf16* XT1 = (const bf16*)(a.ws + WS_XT1); const bf16* PREV = (const bf16*)(a.ws + WS_CST);
    const float* DTS = (const float*)(a.ws + WS_DTS); const float* CS = (const float*)(a.ws + WS_CS);
    float* SSQ = (float*)(a.ws + WS_SSQ); bf16* mix = (bf16*)(a.ws + WS_MIX);
    const int tid = otid(), wave = tid >> 6, lane = tid & 63, r = lane & 31, hh = lane >> 5;
    float* ybuf = smem + wave * 4480;
    float* csl = ybuf + 64 * 68; float* dtl = csl + 64;
    for (int u = obid() * 8 + wave; u < 2048; u += gridDim.x * 8) {
        const int b = u >> 9, c = (u >> 4) & 31, h = u & 15, g = h >> 2;
        const size_t row0 = (size_t)b * SEQ + c * 64;
        csl[lane] = CS[(row0 + lane) * 16 + h]; dtl[lane] = DTS[(row0 + lane) * 16 + h];
        asm volatile("s_waitcnt lgkmcnt(0)" ::: "memory");
        const float Dh = a.in[17][l * 16 + h];
        const bf16* prevb = PREV + ((size_t)((b * 32 + c) * 16 + h)) * 64 * 128;
#pragma unroll 1
        for (int lb = 0; lb < 2; ++lb) {
            bf16x8 cf[8];
#pragma unroll
            for (int kk = 0; kk < 8; ++kk) cf[kk] = ld16(XC + (row0 + lb * 32 + r) * 2048 + 1536 + g * 128 + kk * 16 + 8 * hh);
            f32x16 yo[2]; yo[0] = zero16(); yo[1] = zero16();
#pragma unroll
            for (int pb = 0; pb < 2; ++pb)
#pragma unroll
                for (int kk = 0; kk < 8; ++kk) { const bf16x8 pf = ld16(prevb + (pb * 32 + r) * 128 + kk * 16 + 8 * hh); yo[pb] = MFMA32(pf, cf[kk], yo[pb]); }
            const float csL = csl[lb * 32 + r];
            const float eL = expf(csL);
            f32x16 yd[2]; yd[0] = zero16(); yd[1] = zero16();
#pragma unroll 1
            for (int sb = 0; sb <= lb; ++sb) {
                f32x16 gt = zero16();
#pragma unroll
                for (int kk = 0; kk < 8; ++kk) { const bf16x8 bfm = ld16(XC + (row0 + sb * 32 + r) * 2048 + 1024 + g * 128 + kk * 16 + 8 * hh); gt = MFMA32(bfm, cf[kk], gt); }
                const int lcol = lb * 32 + r;
#pragma unroll
                for (int rg = 0; rg < 16; ++rg) { const int sidx = sb * 32 + crow(rg, hh); const float v = gt[rg] * expf(fminf(csL - csl[sidx], 0.f)) * dtl[sidx]; gt[rg] = (sidx <= lcol) ? v : 0.f; }
#pragma unroll
                for (int s16 = 0; s16 < 2; ++s16) {
                    u32x4 sv; sv.x = pk2(gt[8 * s16 + 0], gt[8 * s16 + 1]); sv.y = pk2(gt[8 * s16 + 2], gt[8 * s16 + 3]); sv.z = pk2(gt[8 * s16 + 4], gt[8 * s16 + 5]); sv.w = pk2(gt[8 * s16 + 6], gt[8 * s16 + 7]);
                    const bf16x8 sf = __builtin_bit_cast(bf16x8, sv);
#pragma unroll
                    for (int pb = 0; pb < 2; ++pb) {
                        const bf16* xp = XT1 + ((size_t)b * 1024 + h * 64 + pb * 32 + r) * 2048 + c * 64 + sb * 32 + 16 * s16 + 4 * hh;
                        const bf16x8 xf = ld8x2(xp, xp + 8);
                        yd[pb] = MFMA32(xf, sf, yd[pb]);
                    }
                }
            }
#pragma unroll
            for (int pb = 0; pb < 2; ++pb)
#pragma unroll
                for (int rg = 0; rg < 16; ++rg) ybuf[(lb * 32 + r) * 68 + pb * 32 + crow(rg, hh)] = yd[pb][rg] + eL * yo[pb][rg];
        }
        asm volatile("s_waitcnt lgkmcnt(0)" ::: "memory");
#pragma unroll 1
        for (int it = 0; it < 8; ++it) {
            const int lrow = it * 8 + (lane >> 3), p8 = (lane & 7) * 8;
            const size_t row = row0 + lrow;
            const float4 y0 = *(const float4*)(ybuf + lrow * 68 + p8), y1 = *(const float4*)(ybuf + lrow * 68 + p8 + 4);
            float x8[8], z8[8];
            unpack8(*(const u32x4*)(XC + row * 2048 + h * 64 + p8), x8);
            unpack8(*(const u32x4*)(proj + row * PP + P_SSDZ + h * 64 + p8), z8);
            const float yy[8] = {y0.x, y0.y, y0.z, y0.w, y1.x, y1.y, y1.z, y1.w};
            float o[8]; float ss = 0.f;
#pragma unroll
            for (int j = 0; j < 8; ++j) { o[j] = (yy[j] + Dh * x8[j]) * siluf(z8[j]); ss = fmaf(o[j], o[j], ss); }
            ss += __shfl_xor(ss, 1); ss += __shfl_xor(ss, 2); ss += __shfl_xor(ss, 4);
            if ((lane & 7) == 0) SSQ[row * 16 + h] = ss;
            u32x4 w; w.x = pk2(o[0], o[1]); w.y = pk2(o[2], o[3]); w.z = pk2(o[4], o[5]); w.w = pk2(o[6], o[7]);
            *(u32x4*)(mix + row * D_MODEL + MX_SSD + h * 64 + p8) = w;
        }
        asm volatile("s_waitcnt lgkmcnt(0)" ::: "memory");
    }
}

__device__ __forceinline__ void phase_ssd_norm(const Args& a, int l) {
    const float* SSQ = (const float*)(a.ws + WS_SSQ);
    bf16* mix = (bf16*)(a.ws + WS_MIX);
    const float* nwp = a.in[18] + (size_t)l * 1024;
    const int tid = otid(), wave = tid >> 6, lane = tid & 63;
    for (int row = obid() * 8 + wave; row < M_TOK; row += gridDim.x * 8) {
        float s = (lane < 16) ? SSQ[(size_t)row * 16 + lane] : 0.f;
        s = wave_sum(s);
        const float rs = 1.0f / sqrtf(s * (1.0f / 1024.f) + EPS);
#pragma unroll
        for (int j = 0; j < 2; ++j) {
            bf16* p = mix + (size_t)row * D_MODEL + MX_SSD + (lane + 64 * j) * 8;
            float v[8]; unpack8(*(const u32x4*)p, v);
            const float4 w0 = *(const float4*)(nwp + (lane + 64 * j) * 8), w1 = *(const float4*)(nwp + (lane + 64 * j) * 8 + 4);
            u32x4 o; o.x = pk2(v[0] * rs * w0.x, v[1] * rs * w0.y); o.y = pk2(v[2] * rs * w0.z, v[3] * rs * w0.w); o.z = pk2(v[4] * rs * w1.x, v[5] * rs * w1.y); o.w = pk2(v[6] * rs * w1.z, v[7] * rs * w1.w);
            *(u32x4*)p = o;
        }
    }
}

__device__ __forceinline__ int t5_bucket(int rel) {
    const int ret = rel > 0 ? 16 : 0; const int n = rel < 0 ? -rel : rel;
    if (n < 8) return ret + n;
    const int e = 31 - __clz(n);
    int v = 8 + 2 * (e - 3) + ((n * n) >= (1 << (2 * e + 1)) ? 1 : 0);
    return ret + (v < 15 ? v : 15);
}

__device__ __forceinline__ void phase_btab(const Args& a) {
    float* bt = (float*)(a.ws + WS_BTAB);
    for (int i = obid() * 512 + otid(); i < 8 * 4096; i += gridDim.x * 512) { const int h = i >> 12, rel = (i & 4095) - 2048; bt[i] = a.in[19][t5_bucket(rel) * 8 + h]; }
}

typedef float f32x4v __attribute__((ext_vector_type(4)));
constexpr int SC_STRIDE = 2052;
__device__ __forceinline__ void dsa_unit(const Args& a, int unit, float* smem) {
    const bf16* proj = (const bf16*)(a.ws + WS_PROJ);
    const float* side = (const float*)(a.ws + WS_SIDE);
    const bf16* VF = (const bf16*)(a.ws + WS_VF); const bf16* KF = (const bf16*)(a.ws + WS_KF); const bf16* IKF = (const bf16*)(a.ws + WS_IKF);
    const float* BT = (const float*)(a.ws + WS_BTAB);
    bf16* mix = (bf16*)(a.ws + WS_MIX);
    float* sc = smem;
    unsigned long long* msk = (unsigned long long*)(smem + 16 * SC_STRIDE);
    const int tid = otid(), wave = tid >> 6, lane = tid & 63, cc = lane & 15, q4 = lane >> 4;
    const int b = unit >> 7, q16 = unit & 127, c = q16 >> 2, nk = 64 * (c + 1);
    const int tq0 = q16 * 16;
    const size_t rowb = (size_t)b * SEQ, rowq = rowb + tq0;
    __syncthreads();
    {
        bf16x8 aq[8][2]; float wq[4][8];
#pragma unroll
        for (int h = 0; h < 8; ++h)
#pragma unroll
            for (int kk = 0; kk < 2; ++kk) aq[h][kk] = ld16(proj + (rowq + cc) * PP + P_IQ + h * 64 + kk * 32 + 8 * q4);
#pragma unroll
        for (int rg = 0; rg < 4; ++rg) {
            const float4 w0 = *(const float4*)(side + (rowq + q4 * 4 + rg) * 32 + 16), w1 = *(const float4*)(side + (rowq + q4 * 4 + rg) * 32 + 20);
            const float sc_ = 0.044194173824159216f;
            wq[rg][0] = w0.x * sc_; wq[rg][1] = w0.y * sc_; wq[rg][2] = w0.z * sc_; wq[rg][3] = w0.w * sc_; wq[rg][4] = w1.x * sc_; wq[rg][5] = w1.y * sc_; wq[rg][6] = w1.z * sc_; wq[rg][7] = w1.w * sc_;
        }
        const int nkb = 4 * (c + 1);
        const bf16* ikb = IKF + (size_t)b * 128 * 2 * 512 + lane * 8;
        bf16x8 nb0 = ld16(ikb + (size_t)wave * 1024), nb1 = ld16(ikb + (size_t)wave * 1024 + 512);
#pragma unroll 1
        for (int kb = wave; kb < nkb; kb += 8) {
            const int key0 = kb * 16;
            const bf16x8 bk0 = nb0, bk1 = nb1;
            { const int kn = (kb + 8 < nkb) ? kb + 8 : kb; nb0 = ld16(ikb + (size_t)kn * 1024); nb1 = ld16(ikb + (size_t)kn * 1024 + 512); }
            f32x4v s4 = {0.f, 0.f, 0.f, 0.f};
#pragma unroll
            for (int h = 0; h < 8; ++h) {
                f32x4v acc = {0.f, 0.f, 0.f, 0.f};
                acc = MFMA16(aq[h][0], bk0, acc); acc = MFMA16(aq[h][1], bk1, acc);
#pragma unroll
                for (int rg = 0; rg < 4; ++rg) s4[rg] = fmaf(fmaxf(acc[rg], 0.f), wq[rg][h], s4[rg]);
            }
#pragma unroll
            for (int rg = 0; rg < 4; ++rg) sc[(q4 * 4 + rg) * SC_STRIDE + key0 + cc] = s4[rg] + 0.0f;
        }
    }
    __syncthreads();
#pragma unroll 1
    for (int qq = 0; qq < 2; ++qq) {
        const int q = wave * 2 + qq;
        if (nk <= 256) {
            if (lane <= c) msk[q * 32 + lane] = ~0ull;
        } else {
            unsigned key[32];
#pragma unroll
            for (int r = 0; r < 32; ++r) {
                key[r] = 0u;
                if (r <= c) { const unsigned u = __float_as_uint(sc[q * SC_STRIDE + r * 64 + lane]); key[r] = (u & 0x80000000u) ? ~u : (u | 0x80000000u); }
            }
            unsigned T = 0u; bool exact = false;
#pragma unroll 1
            for (int bit = 31; bit >= 0; --bit) {
                const unsigned cand = T | (1u << bit);
                int cnt = 0;
#pragma unroll
                for (int r = 0; r < 32; ++r) if (r <= c) cnt += __popcll(__ballot(key[r] >= cand));
                if (cnt >= 256) T = cand;
                if (cnt == 256) { exact = true; break; }
            }
            if (exact) {
#pragma unroll
                for (int r = 0; r < 32; ++r) if (r <= c) { const unsigned long long m = __ballot(key[r] >= T); if (lane == 0) msk[q * 32 + r] = m; }
            } else {
                int cgt = 0;
#pragma unroll
                for (int r = 0; r < 32; ++r) if (r <= c) cgt += __popcll(__ballot(key[r] > T));
                int need = 256 - cgt;
#pragma unroll
                for (int r = 0; r < 32; ++r) if (r <= c) {
                    const unsigned long long gm = __ballot(key[r] > T); unsigned long long em = __ballot(key[r] == T);
                    const int pc = __popcll(em);
                    if (pc <= need) need -= pc;
                    else { while (__popcll(em) > need) em &= ~(1ull << (63 - __clzll((long long)em))); need = 0; }
                    if (lane == 0) msk[q * 32 + r] = gm | em;
                }
            }
        }
    }
    __syncthreads();
    {
        const int h = wave;
        const bf16x8 bq0 = ld16(proj + (rowq + cc) * PP + P_AQ + h * 64 + 8 * q4), bq1 = ld16(proj + (rowq + cc) * PP + P_AQ + h * 64 + 32 + 8 * q4);
        f32x4v o[4];
#pragma unroll
        for (int dt = 0; dt < 4; ++dt) o[dt] = (f32x4v){0.f, 0.f, 0.f, 0.f};
        float m = -INFINITY, lsum = 0.f;
        const float* bth = BT + h * 4096 + 2048 - (tq0 + cc);
        const int nst = 2 * (c + 1);
        const bf16* kfb = KF + (size_t)b * 64 * 2048 + lane * 8;
        const bf16* vfb = VF + (size_t)b * 64 * 2048 + lane * 8;
        const float* bbp = bth + q4 * 4;
        bf16x8 nk00 = ld16(kfb), nk01 = ld16(kfb + 512), nk10 = ld16(kfb + 1024), nk11 = ld16(kfb + 1536);
        bf16x8 nvf[4];
#pragma unroll
        for (int dt = 0; dt < 4; ++dt) nvf[dt] = ld16(vfb + dt * 512);
        float4 nba = *(const float4*)bbp, nbb = *(const float4*)(bbp + 16);
#pragma unroll 1
        for (int ks = 0; ks < nst; ++ks) {
            const int kbase = ks * 32;
            const bf16x8 k00 = nk00, k01 = nk01, k10 = nk10, k11 = nk11;
            bf16x8 vf[4];
#pragma unroll
            for (int dt = 0; dt < 4; ++dt) vf[dt] = nvf[dt];
            const float4 ba = nba, bb = nbb;
            {
                const int ksn = (ks + 1 < nst) ? ks + 1 : ks;
                const bf16* kp = kfb + (size_t)ksn * 2048;
                nk00 = ld16(kp); nk01 = ld16(kp + 512); nk10 = ld16(kp + 1024); nk11 = ld16(kp + 1536);
                const bf16* vp = vfb + (size_t)ksn * 2048;
#pragma unroll
                for (int dt = 0; dt < 4; ++dt) nvf[dt] = ld16(vp + dt * 512);
                nba = *(const float4*)(bbp + ksn * 32); nbb = *(const float4*)(bbp + ksn * 32 + 16);
            }
            f32x4v s0 = {0.f, 0.f, 0.f, 0.f}, s1 = {0.f, 0.f, 0.f, 0.f};
            s0 = MFMA16(k00, bq0, s0); s0 = MFMA16(k01, bq1, s0);
            s1 = MFMA16(k10, bq0, s1); s1 = MFMA16(k11, bq1, s1);
            const unsigned long long mw = msk[cc * 32 + (kbase >> 6)];
            const unsigned bits = (unsigned)(mw >> ((kbase & 63) + q4 * 4));
            const float bia[8] = {ba.x, ba.y, ba.z, ba.w, bb.x, bb.y, bb.z, bb.w};
            float lg[8]; float mx = -INFINITY;
#pragma unroll
            for (int rg = 0; rg < 4; ++rg) {
                lg[rg] = ((bits >> rg) & 1u) ? fmaf(s0[rg], 0.125f, bia[rg]) : -INFINITY;
                lg[4 + rg] = ((bits >> (16 + rg)) & 1u) ? fmaf(s1[rg], 0.125f, bia[4 + rg]) : -INFINITY;
                mx = fmaxf(mx, fmaxf(lg[rg], lg[4 + rg]));
            }
            mx = fmaxf(mx, __shfl_xor(mx, 16)); mx = fmaxf(mx, __shfl_xor(mx, 32));
            const float mn = fmaxf(m, mx);
            const float alpha = (mn == -INFINITY) ? 1.f : __expf(m - mn);
            const float msub = (mn == -INFINITY) ? 0.f : mn;
            float p[8]; float ps = 0.f;
#pragma unroll
            for (int j = 0; j < 8; ++j) { p[j] = __expf(lg[j] - msub); ps += p[j]; }
            lsum = fmaf(lsum, alpha, ps); m = mn;
            u32x4 pv; pv.x = pk2(p[0], p[1]); pv.y = pk2(p[2], p[3]); pv.z = pk2(p[4], p[5]); pv.w = pk2(p[6], p[7]);
            const bf16x8 pf = __builtin_bit_cast(bf16x8, pv);
#pragma unroll
            for (int dt = 0; dt < 4; ++dt) { o[dt] = o[dt] * alpha; o[dt] = MFMA16(vf[dt], pf, o[dt]); }
        }
        lsum += __shfl_xor(lsum, 16); lsum += __shfl_xor(lsum, 32);
        const float inv = 1.0f / lsum;
#pragma unroll
        for (int dt = 0; dt < 4; ++dt) {
            const int d0 = dt * 16 + q4 * 4;
            const float4 z = ldbf4(proj + (rowq + cc) * PP + P_AZ + h * 64 + d0);
            u32x2 w; w.x = pk2(o[dt][0] * inv * siluf(z.x), o[dt][1] * inv * siluf(z.y)); w.y = pk2(o[dt][2] * inv * siluf(z.z), o[dt][3] * inv * siluf(z.w));
            *(u32x2*)(mix + (rowq + cc) * D_MODEL + MX_ATT + h * 64 + d0) = w;
        }
    }
}
__device__ __forceinline__ void phase_dsa(const Args& a, int l, float* smem) {
    for (int k = obid(); k < 256; k += gridDim.x) { dsa_unit(a, k, smem); dsa_unit(a, 511 - k, smem); }
}

#define XB_TMO      128
#define XB_XCNT(j)  (256  + 64 * (j))
#define XB_XSUB(j)  (1280 + 64 * (j))
#define XB_XGEN(j)  (2304 + 64 * (j))
#define XB_TOP      3328
#define XB_TOPGEN   3392
#define XCD_BAR_WORDS 3456
#define XB_SPIN_CAP (1u << 18)

__device__ __forceinline__ unsigned xb_ld(unsigned* p)              { return __hip_atomic_load(p, __ATOMIC_RELAXED, __HIP_MEMORY_SCOPE_AGENT); }
__device__ __forceinline__ unsigned xb_add(unsigned* p, unsigned v) { return __hip_atomic_fetch_add(p, v, __ATOMIC_RELAXED, __HIP_MEMORY_SCOPE_AGENT); }
__device__ __forceinline__ unsigned xb_xcc_id() { return (unsigned)__builtin_amdgcn_s_getreg((3 << 11) | 20) & 0xFu; }
#define XB_SPIN(cond, bar) do { unsigned _sp = 0; while (cond) { __builtin_amdgcn_s_sleep(1); \
    if ((++_sp & 255u) == 0u) { if (xb_ld(&(bar)[XB_TMO])) break; if (_sp > XB_SPIN_CAP) { atomicAdd(&(bar)[XB_TMO], 1u); break; } } } } while (0)

struct XcdBarrier {
    unsigned* bar; unsigned x;
    volatile LAS unsigned* st;
};

__device__ __forceinline__ XcdBarrier xcd_barrier_post(unsigned* bar, volatile LAS unsigned* st) {
    XcdBarrier b; b.bar = bar; b.x = xb_xcc_id(); b.st = st;
    if (threadIdx.x == 0) (void)xb_add(&bar[XB_XCNT(b.x)], 1u);
    return b;
}
__device__ __forceinline__ void xcd_barrier_complete(unsigned* bar, unsigned x, unsigned& nloc, unsigned& nx) {
    const unsigned G = gridDim.x * gridDim.y * gridDim.z;
    unsigned sum, cnt, mine, sp = 0u;
    for (;;) {
        sum = 0u; cnt = 0u; mine = 0u;
#pragma unroll
        for (unsigned j = 0; j < 16; ++j) { const unsigned c = xb_ld(&bar[XB_XCNT(j)]); sum += c; cnt += (c > 0u) ? 1u : 0u; mine = (j == x) ? c : mine; }
        if (sum == G) break;
        __builtin_amdgcn_s_sleep(1);
        if ((++sp & 255u) == 0u) { if (xb_ld(&bar[XB_TMO])) break; if (sp > XB_SPIN_CAP) { atomicAdd(&bar[XB_TMO], 1u); break; } }
    }
    nloc = mine > 0u ? mine : 1u; nx = cnt > 0u ? cnt : 1u;
}

__device__ __forceinline__ void xcd_barrier(const XcdBarrier& b) {
    asm volatile("s_waitcnt vmcnt(0)" ::: "memory");
    __syncthreads();
    if (threadIdx.x == 0) {
        unsigned* bar = b.bar;
        __builtin_amdgcn_s_waitcnt(0);
        unsigned nloc = b.st[0], nx = b.st[1];
        if (nloc == 0u) { xcd_barrier_complete(bar, b.x, nloc, nx); b.st[0] = nloc; b.st[1] = nx; }
        const unsigned old = xb_add(&bar[XB_XSUB(b.x)], 1u);
        const unsigned gen = old / nloc;
        if (old + 1u == (gen + 1u) * nloc) {
            __builtin_amdgcn_fence(__ATOMIC_RELEASE, "agent");
            asm volatile("s_waitcnt vmcnt(0)" ::: "memory");
            const unsigned og = xb_add(&bar[XB_TOP], 1u);
            const unsigned tg = og / nx;
            if (og + 1u == (tg + 1u) * nx) xb_add(&bar[XB_TOPGEN], 1u);
            else XB_SPIN(xb_ld(&bar[XB_TOPGEN]) == tg, bar);
            __builtin_amdgcn_fence(__ATOMIC_ACQUIRE, "agent");
            xb_add(&bar[XB_XGEN(b.x)], 1u);
            asm volatile("s_waitcnt vmcnt(0)" ::: "memory");
        } else {
            XB_SPIN(xb_ld(&bar[XB_XGEN(b.x)]) == gen, bar);
            __builtin_amdgcn_fence(__ATOMIC_ACQUIRE, "agent");
            asm volatile("s_waitcnt vmcnt(0)" ::: "memory");
        }
    }
    __syncthreads();
}


constexpr int LDS_BYTES = 147456;
__global__ void __launch_bounds__(512, 2) mk_fwd(Args a) {
    extern __shared__ __attribute__((aligned(16))) unsigned char lds[];
    float* smem = (float*)lds;
    cg::grid_group grid = cg::this_grid();
    const int G = gridDim.x;
    volatile LAS unsigned* MISC = (volatile LAS unsigned*)((LAS unsigned char*)lds + (LDS_BYTES - 256));
    if (threadIdx.x < 64) MISC[threadIdx.x] = 0u;
    __syncthreads();
    XcdBarrier bar = xcd_barrier_post((unsigned*)(a.ws + WS_CTL) + 4096, MISC + 8);
    bf16* XB = (bf16*)(a.ws + WS_XB); bf16* PROJ = (bf16*)(a.ws + WS_PROJ); bf16* MIX = (bf16*)(a.ws + WS_MIX); bf16* YG = (bf16*)(a.ws + WS_YG);
    phase_prologue(a, smem);
    phase_btab(a);
    grid.sync();
    for (int l = 0; l < DEPTH; ++l) {
        const float* xcur = (l == 0) ? a.in[0] : a.out;
        {
            pg8::Gemm g{XB, (const bf16*)(a.ws + WS_WIN + l * WIN_L), M_TOK, PP, D_MODEL}; pg8::StaticOrder S; S.init(M_TOK, PP, G, obid());
            EpiProj E{PROJ, (float*)(a.ws + WS_SIDE), (bf16*)(a.ws + WS_VF), (bf16*)(a.ws + WS_KF), (bf16*)(a.ws + WS_IKF)};
            pg8::gemm_phase<EpiProj, pg8::StaticOrder, true, true>((LAS unsigned char*)lds, g, S, E);
        }
        xcd_barrier(bar);
        phase_s5(a, l, smem);
        phase_ssd_pre(a, l, smem);
        phase_dsa(a, l, smem);
        xcd_barrier(bar);
        {
            pg8::Gemm g{YG, (const bf16*)(a.ws + WS_WGLU + l * WGLU_L), M_TOK, 512, 512}; pg8::StaticOrder S; S.init(M_TOK, 512, G, obid());
            EpiGlu E{YG, PROJ, a.in[12] + (size_t)l * 512, MIX};
            pg8::gemm_phase<EpiGlu, pg8::StaticOrder, true, true>((LAS unsigned char*)lds, g, S, E);
        }
        phase_ssd1(a);
        xcd_barrier(bar);
        phase_ssd2(a);
        xcd_barrier(bar);
        phase_ssd3(a, l, smem);
        xcd_barrier(bar);
        phase_ssd_norm(a, l);
        xcd_barrier(bar);
        {
            pg8::Gemm g{MIX, (const bf16*)(a.ws + WS_WOUT + l * WOUT_L), M_TOK, D_MODEL, D_MODEL}; pg8::StaticOrder S; S.init(M_TOK, D_MODEL, G, obid());
            EpiOut E{xcur, a.out};
            pg8::gemm_phase<EpiOut, pg8::StaticOrder, true, true>((LAS unsigned char*)lds, g, S, E);
        }
        xcd_barrier(bar);
        if (l + 1 < DEPTH) { phase_rmsnorm_bf16(a.out, a.in[1] + (size_t)(l + 1) * D_MODEL, XB); xcd_barrier(bar); }
    }
    phase_rmsnorm_f32(a.out, a.in[21], a.out);
}

extern "C" void kernel_launch(void* const* d_in, const int* in_sizes, int n_in, void* d_out, int out_size, void* d_ws, size_t ws_size, hipStream_t stream) {
    if (n_in != 22 || out_size != M_TOK * D_MODEL || ws_size < WS_END) {
        fprintf(stderr, "kernel_launch: unexpected problem: n_in %d out %d ws %zu\n", n_in, out_size, ws_size);
        return;
    }
    static int grid_blocks = 0;
    if (!grid_blocks) {
        int dev = 0, cus = 0, per_cu = 0;
        (void)hipGetDevice(&dev);
        (void)hipDeviceGetAttribute(&cus, hipDeviceAttributeMultiprocessorCount, dev);
        (void)hipFuncSetAttribute((const void*)mk_fwd, hipFuncAttributeMaxDynamicSharedMemorySize, LDS_BYTES);
        (void)hipOccupancyMaxActiveBlocksPerMultiprocessor(&per_cu, (const void*)mk_fwd, 512, LDS_BYTES);
        if (per_cu < 1) fprintf(stderr, "kernel_launch: occupancy query says %d blocks/CU\n", per_cu);
        grid_blocks = cus;
    }
    Args a{};
    for (int i = 0; i < 22; ++i) a.in[i] = (const float*)d_in[i];
    a.out = (float*)d_out; a.ws = (unsigned char*)d_ws;
    (void)hipMemsetAsync((char*)d_ws + WS_CTL, 0, 65536, stream);
    void* args[] = {&a};
    hipError_t e = hipLaunchCooperativeKernel((void*)mk_fwd, dim3(grid_blocks), dim3(512), args, LDS_BYTES, stream);
    if (e != hipSuccess) fprintf(stderr, "cooperative launch failed: %s (grid %d)\n", hipGetErrorString(e), grid_blocks);
}
```

```cpp
#include <hip/hip_runtime.h>
#include <cstdint>
#include <cstdio>
#include <hip/hip_cooperative_groups.h>
namespace cg = cooperative_groups;

__device__ __forceinline__ int otid() { int t = threadIdx.x; asm volatile("" : "+v"(t)); return t; }
__device__ __forceinline__ int obid() { int b = blockIdx.x; asm volatile("" : "+s"(b)); return b; }
namespace pg8 {
#define PG8_LAS __attribute__((address_space(3)))
typedef unsigned short bf16_t;
typedef short bf16x8 __attribute__((ext_vector_type(8)));
typedef float f32x4 __attribute__((ext_vector_type(4)));
typedef unsigned u32x4 __attribute__((ext_vector_type(4)));
constexpr int BM = 256, BK = 64, HALF = 128, HTB = HALF * BK * 2  , STAGE_BYTES = 8 * HTB, NXCD = 8, WGM = 8;

__host__ __device__ __forceinline__ int lds_byte(int r, int c) { const int st = (r >> 4) * 2 + (c >> 5), rr = r & 15, cc = c & 31, ob = rr * 64 + cc * 2; return st * 1024 + (ob ^ (((ob >> 9) & 1) << 5)); }
__host__ __device__ __forceinline__ void stage_rc(int b, int& R, int& C) { const int st = b / 1024, sb = b % 1024, swz = sb ^ (((sb >> 9) & 1) << 5); R = (st >> 1) * 16 + swz / 64; C = (st & 1) * 32 + (swz % 64) / 2; }
__host__ __device__ __forceinline__ int perm32(int rho) { const int n = rho >> 4, i = rho & 15; return 8 * (i >> 2) + 4 * n + (i & 3); }

struct Unit { int pm, pn; };
struct Gemm { const bf16_t* A; const bf16_t* Bt; int M, N, K; };

struct StaticOrder {
    int nM, nN, nwg, G, c;
    __host__ __device__ void init(int M, int N, int G_, int c_) { nM = M / BM; nN = N / BM; nwg = nM * nN; G = G_; c = c_; }
    __host__ __device__ bool next(int i, Unit& u) const {
        const long L = (long)i * G + c; if (L >= nwg) return false;
        int wgid = (int)L; { const int q = nwg / NXCD, r = nwg % NXCD, xcd = wgid % NXCD, off = wgid / NXCD; wgid = (xcd < r ? xcd * (q + 1) : r * (q + 1) + (xcd - r) * q) + off; }
        const int nig = WGM * nN, gid = wgid / nig, fm = gid * WGM, gsz = (nM - fm) < WGM ? (nM - fm) : WGM;
        u.pm = fm + ((wgid % nig) % gsz); u.pn = (wgid % nig) / gsz; return true;
    }
    __device__ __forceinline__ void a_ready(const Unit&) const {}
    __device__ __forceinline__ void done(const Unit&) const {}
};


__device__ __forceinline__ unsigned cvt_pk_bf16(float lo, float hi) { unsigned r; asm volatile("v_cvt_pk_bf16_f32 %0, %1, %2" : "=v"(r) : "v"(lo), "v"(hi)); return r; }
template <class Epi, class Sched, bool ALIGN_EPI = false, bool SP2 = false>
__device__ __forceinline__ void gemm_phase(PG8_LAS unsigned char* lds, const Gemm g, const Sched& S, const Epi& E) {
    const int tid = otid(), wid = __builtin_amdgcn_readfirstlane(tid >> 6), lane = tid & 63, wr = wid >> 2, wc = wid & 3, fr = lane & 15, fq = lane >> 4;
    const int K = g.K, nt = K / BK;
    unsigned voffA[2], voffB[2];
#pragma unroll
    for (int i = 0; i < 2; ++i) { int R, C; stage_rc(tid * 16 + i * 8192, R, C); const int Rb = Epi::PERM ? ((R & ~31) + perm32(R & 31)) : R;
        voffA[i] = (unsigned)(R * K + C) * 2u; voffB[i] = (unsigned)(Rb * K + C) * 2u; }
    const size_t kstep = (size_t)(BK * 2);
    const size_t hstep = (size_t)HALF * K * 2;
    const size_t tstep = 2 * hstep;
    const unsigned ldsw = (unsigned)wid * 1024u;
    const int aoff = lds_byte(wr * 64 + fr, fq * 8), boff = lds_byte(wc * 32 + fr, fq * 8);
#define PG8_SA(b, h) (((b) * 2 + (h)) * HTB)
#define PG8_SB(b, h) ((4 + (b) * 2 + (h)) * HTB)
#define PG8_STAGE(bufoff, gbase, voff) do { _Pragma("unroll") for (int _i = 0; _i < 2; ++_i) \
        __builtin_amdgcn_global_load_lds((const unsigned*)((const char*)(gbase) + (voff)[_i]), (PG8_LAS unsigned*)(lds + (bufoff) + ldsw + _i * 8192), 16, 0, 0); } while (0)
#define PG8_LDA(dst, b, h) do { _Pragma("unroll") for (int m = 0; m < 4; ++m) _Pragma("unroll") for (int k = 0; k < 2; ++k) dst[m][k] = *(const PG8_LAS bf16x8*)(lds + PG8_SA(b, h) + aoff + m * 2048 + k * 1024); } while (0)
#define PG8_LDB(dst, b, h) do { _Pragma("unroll") for (int n = 0; n < 2; ++n) _Pragma("unroll") for (int k = 0; k < 2; ++k) dst[n][k] = *(const PG8_LAS bf16x8*)(lds + PG8_SB(b, h) + boff + n * 2048 + k * 1024); } while (0)
#define PG8_MMA(ai, bj, At, Bt) do { __builtin_amdgcn_s_setprio(1); _Pragma("unroll") for (int m = 0; m < 4; ++m) _Pragma("unroll") for (int n = 0; n < 2; ++n) _Pragma("unroll") for (int k = 0; k < 2; ++k) \
        acc[ai][bj][m][n] = __builtin_amdgcn_mfma_f32_16x16x32_bf16(Bt[n][k], At[m][k], acc[ai][bj][m][n], 0, 0, 0); __builtin_amdgcn_s_setprio(0); } while (0)
#define PG8_WAIT_V(n) asm volatile("s_waitcnt vmcnt(" #n ")" ::: "memory")
#define PG8_WAIT_L(n) asm volatile("s_waitcnt lgkmcnt(" #n ")" ::: "memory")
#define PG8_BAR __builtin_amdgcn_s_barrier()
#define PG8_SCHED __builtin_amdgcn_sched_barrier(0)
    Unit cur, nxt; int ui = 0;
    if (!S.next(0, cur)) return;
    f32x4 acc[2][2][4][2];
#pragma unroll
    for (int a = 0; a < 2; ++a)
#pragma unroll
        for (int b = 0; b < 2; ++b)
#pragma unroll
            for (int m = 0; m < 4; ++m)
#pragma unroll
                for (int n = 0; n < 2; ++n) acc[a][b][m][n] = (f32x4){0.f, 0.f, 0.f, 0.f};
    bf16x8 At[4][2], B0[2][2], B1[2][2];
    const char* cA = (const char*)g.A + (size_t)cur.pm * tstep; const char* cB = (const char*)g.Bt + (size_t)cur.pn * tstep;
    S.a_ready(cur);
    if constexpr (SP2) {
        PG8_STAGE(PG8_SB(0, 0), cB, voffB); PG8_STAGE(PG8_SB(0, 1), cB + hstep, voffB); PG8_STAGE(PG8_SA(0, 0), cA, voffA); PG8_STAGE(PG8_SA(0, 1), cA + hstep, voffA);
        if (wr == 1) PG8_BAR;
        PG8_WAIT_V(2); PG8_BAR;
        PG8_STAGE(PG8_SB(1, 0), cB + kstep, voffB); PG8_STAGE(PG8_SA(1, 0), cA + kstep, voffA); PG8_STAGE(PG8_SB(1, 1), cB + hstep + kstep, voffB);
        PG8_WAIT_V(6); PG8_BAR;
    } else {
        PG8_STAGE(PG8_SB(0, 0), cB, voffB); PG8_STAGE(PG8_SA(0, 0), cA, voffA); PG8_STAGE(PG8_SB(0, 1), cB + hstep, voffB); PG8_STAGE(PG8_SA(0, 1), cA + hstep, voffA);
        if (wr == 1) PG8_BAR;
        PG8_WAIT_V(4); PG8_BAR;
        PG8_STAGE(PG8_SB(1, 0), cB + kstep, voffB); PG8_STAGE(PG8_SA(1, 0), cA + kstep, voffA); PG8_STAGE(PG8_SB(1, 1), cB + hstep + kstep, voffB);
        PG8_WAIT_V(6); PG8_BAR;
    }
    for (;;) {
        const bool has_next = S.next(ui + 1, nxt);
        const char* nA = has_next ? (const char*)g.A + (size_t)nxt.pm * tstep : cA; const char* nB = has_next ? (const char*)g.Bt + (size_t)nxt.pn * tstep : cB;
        for (int t = 0; t < nt; t += 2) {
            const bool last = (t == nt - 2);
            const char* a1 = cA + (size_t)(t + 1) * kstep;
            const char* a2 = last ? nA : cA + (size_t)(t + 2) * kstep; const char* b2 = last ? nB : cB + (size_t)(t + 2) * kstep;
            const char* a3 = a2 + kstep; const char* b3 = b2 + kstep;
            if (last && has_next) S.a_ready(nxt);
            if constexpr (SP2) {
            PG8_LDB(B0, 0, 0); PG8_LDB(B1, 0, 1); PG8_SCHED; PG8_LDA(At, 0, 0); PG8_STAGE(PG8_SA(1, 1), a1 + hstep, voffA);
            PG8_WAIT_V(8); PG8_WAIT_L(0); PG8_BAR; PG8_MMA(0, 0, At, B0); PG8_MMA(0, 1, At, B1); PG8_BAR; PG8_SCHED;
            PG8_LDA(At, 0, 1); PG8_STAGE(PG8_SB(0, 0), b2, voffB); PG8_STAGE(PG8_SB(0, 1), b2 + hstep, voffB); PG8_STAGE(PG8_SA(0, 0), a2, voffA);
            PG8_WAIT_V(8); PG8_WAIT_L(0); PG8_BAR; PG8_MMA(1, 0, At, B0); PG8_MMA(1, 1, At, B1); PG8_BAR; PG8_SCHED;
            PG8_LDB(B0, 1, 0); PG8_LDB(B1, 1, 1); PG8_SCHED; PG8_LDA(At, 1, 0); PG8_STAGE(PG8_SA(0, 1), a2 + hstep, voffA);
            PG8_WAIT_V(8); PG8_WAIT_L(0); PG8_BAR; PG8_MMA(0, 0, At, B0); PG8_MMA(0, 1, At, B1); PG8_BAR; PG8_SCHED;
            PG8_LDA(At, 1, 1); PG8_STAGE(PG8_SB(1, 0), b3, voffB); PG8_STAGE(PG8_SB(1, 1), b3 + hstep, voffB); PG8_STAGE(PG8_SA(1, 0), a3, voffA);
            PG8_WAIT_V(8); PG8_WAIT_L(0); PG8_BAR; PG8_MMA(1, 0, At, B0); PG8_MMA(1, 1, At, B1); PG8_BAR; PG8_SCHED;
            } else {
            PG8_LDB(B0, 0, 0); PG8_SCHED; PG8_LDA(At, 0, 0); PG8_STAGE(PG8_SA(1, 1), a1 + hstep, voffA);
            PG8_WAIT_L(8); PG8_BAR; PG8_WAIT_L(0); PG8_MMA(0, 0, At, B0); PG8_BAR; PG8_SCHED;
            PG8_LDB(B1, 0, 1); PG8_STAGE(PG8_SB(0, 0), b2, voffB);
            PG8_BAR; PG8_WAIT_L(0); PG8_MMA(0, 1, At, B1); PG8_BAR;
            PG8_LDA(At, 0, 1); PG8_STAGE(PG8_SA(0, 0), a2, voffA);
            PG8_BAR; PG8_WAIT_L(0); PG8_MMA(1, 0, At, B0); PG8_BAR; PG8_SCHED;
            PG8_STAGE(PG8_SB(0, 1), b2 + hstep, voffB);
            PG8_WAIT_V(6); PG8_BAR; PG8_MMA(1, 1, At, B1); PG8_BAR;
            PG8_LDB(B0, 1, 0); PG8_SCHED; PG8_LDA(At, 1, 0); PG8_STAGE(PG8_SA(0, 1), a2 + hstep, voffA);
            PG8_WAIT_L(8); PG8_BAR; PG8_WAIT_L(0); PG8_MMA(0, 0, At, B0); PG8_BAR; PG8_SCHED;
            PG8_LDB(B1, 1, 1); PG8_STAGE(PG8_SB(1, 0), b3, voffB);
            PG8_BAR; PG8_WAIT_L(0); PG8_MMA(0, 1, At, B1); PG8_BAR;
            PG8_LDA(At, 1, 1); PG8_STAGE(PG8_SA(1, 0), a3, voffA);
            PG8_BAR; PG8_WAIT_L(0); PG8_MMA(1, 0, At, B0); PG8_BAR; PG8_SCHED;
            PG8_STAGE(PG8_SB(1, 1), b3 + hstep, voffB);
            PG8_WAIT_V(6); PG8_BAR; PG8_MMA(1, 1, At, B1); PG8_BAR;
            }
        }
        if constexpr (ALIGN_EPI) { if (wr == 0) PG8_BAR; }
        if constexpr (!Epi::AFTER_DRAIN) { E(acc, cur, wr, wc, fr, fq); S.done(cur); }
        if (!has_next) break;
#pragma unroll
        for (int a = 0; a < 2; ++a)
#pragma unroll
            for (int b = 0; b < 2; ++b)
#pragma unroll
                for (int m = 0; m < 4; ++m)
#pragma unroll
                    for (int n = 0; n < 2; ++n) acc[a][b][m][n] = (f32x4){0.f, 0.f, 0.f, 0.f};
        cur = nxt; cA = nA; cB = nB; ++ui;
        if constexpr (ALIGN_EPI) { if (wr == 1) PG8_BAR; }
    }
    PG8_WAIT_V(0);
    if constexpr (!ALIGN_EPI) { if (wr == 0) PG8_BAR; }
    PG8_BAR;
    if constexpr (Epi::AFTER_DRAIN) { E.fused(acc, cur, wr, wc, fr, fq, lds, wid, lane); S.done(cur); }
#undef PG8_SA
#undef PG8_SB
#undef PG8_STAGE
#undef PG8_LDA
#undef PG8_LDB
#undef PG8_MMA
#undef PG8_WAIT_V
#undef PG8_WAIT_L
#undef PG8_BAR
#undef PG8_SCHED
}
}

constexpr int D_MODEL = 2048, BATCH = 4, SEQ = 2048, DEPTH = 2;
constexpr int M_TOK = BATCH * SEQ;
constexpr int D_IN = 5848;
constexpr float EPS = 1e-6f;
constexpr int PP = 5888;
constexpr int P_S5U = 0, P_S5Z = 512, P_SSDZ = 1024, P_XBC = 2048, P_AQ = 4096, P_IQ = 4608, P_AZ = 5120, P_AK = 5632, P_AV = 5696, P_IK = 5760, P_DT = 5824, P_IW = 5840;
constexpr int MX_S5 = 0, MX_SSD = 512, MX_ATT = 1536;

typedef unsigned short bf16;
typedef unsigned u32x4 __attribute__((ext_vector_type(4)));
typedef unsigned u32x2 __attribute__((ext_vector_type(2)));
typedef float f32x4 __attribute__((ext_vector_type(4)));
#define LAS __attribute__((address_space(3)))

constexpr size_t MiB = 1u << 20;
constexpr size_t WS_CTL = 0;
constexpr size_t WS_WIN = 2 * MiB;
constexpr size_t WIN_L = (size_t)PP * 2048 * 2;
constexpr size_t WS_WOUT = 48 * MiB;
constexpr size_t WOUT_L = (size_t)2048 * 2048 * 2;
constexpr size_t WS_WGLU = 64 * MiB;
constexpr size_t WGLU_L = (size_t)512 * 512 * 2;
constexpr size_t WS_S5P = 65 * MiB;
constexpr size_t WS_SIDE = 66 * MiB;
constexpr size_t WS_XB = 68 * MiB;
constexpr size_t WS_PROJ = 100 * MiB;
constexpr size_t WS_MIX = 192 * MiB;
constexpr size_t WS_YG = 224 * MiB;
constexpr size_t WS_DTS = 67 * MiB;
constexpr size_t WS_CS = WS_DTS + 512 * 1024;
constexpr size_t WS_XC = 232 * MiB;
constexpr size_t WS_XT1 = 264 * MiB;
constexpr size_t WS_XT2 = 280 * MiB;
constexpr size_t WS_BTR = 296 * MiB;
constexpr size_t WS_CST = 304 * MiB;
constexpr size_t WS_SSQ = 336 * MiB;
constexpr size_t WS_BTAB = 336 * MiB + 512 * 1024;
constexpr size_t WS_VF = 337 * MiB;
constexpr size_t WS_KF = 338 * MiB;
constexpr size_t WS_IKF = 339 * MiB;
constexpr size_t WS_END = 340 * MiB;
static_assert(WS_WIN + 2 * WIN_L <= WS_WOUT && WS_WOUT + 2 * WOUT_L <= WS_WGLU, "ws map");

struct Args {
    const float* in[22];
    float* out;
    unsigned char* ws;
};

__device__ __forceinline__ float bf2f(unsigned v) { return __uint_as_float(v << 16); }
__device__ __forceinline__ unsigned f2bf(float f) { unsigned u = __float_as_uint(f); return (u + 0x7fffu + ((u >> 16) & 1u)) >> 16; }
__device__ __forceinline__ unsigned pk2(float lo, float hi) { return f2bf(lo) | (f2bf(hi) << 16); }
__device__ __forceinline__ float4 ldbf4(const bf16* p) { const u32x2 u = *(const u32x2*)p; float4 r; r.x = __uint_as_float(u.x << 16); r.y = __uint_as_float(u.x & 0xffff0000u); r.z = __uint_as_float(u.y << 16); r.w = __uint_as_float(u.y & 0xffff0000u); return r; }
__device__ __forceinline__ void unpack8(const u32x4 u, float* f) {
    f[0] = __uint_as_float(u.x << 16); f[1] = __uint_as_float(u.x & 0xffff0000u); f[2] = __uint_as_float(u.y << 16); f[3] = __uint_as_float(u.y & 0xffff0000u);
    f[4] = __uint_as_float(u.z << 16); f[5] = __uint_as_float(u.z & 0xffff0000u); f[6] = __uint_as_float(u.w << 16); f[7] = __uint_as_float(u.w & 0xffff0000u);
}

__device__ __forceinline__ float wave_sum(float v) {
#pragma unroll
    for (int o = 1; o < 64; o <<= 1) v += __shfl_xor(v, o);
    return v;
}
__device__ __forceinline__ float wave_max(float v) {
#pragma unroll
    for (int o = 1; o < 64; o <<= 1) v = fmaxf(v, __shfl_xor(v, o));
    return v;
}
__device__ __forceinline__ float siluf(float x) { return x / (1.0f + expf(-x)); }
__device__ __forceinline__ float sigmoidf_(float x) { return 1.0f / (1.0f + expf(-x)); }
__device__ __forceinline__ float gelu_tanh(float x) { return 0.5f * x * (1.0f + tanhf(0.7978845608028654f * (x + 0.044715f * x * x * x))); }
__device__ __forceinline__ float softplusf_(float x) { return fmaxf(x, 0.f) + log1pf(expf(-fabsf(x))); }

struct EpiProj {
    static constexpr bool PERM = true, AFTER_DRAIN = false;
    bf16* P; float* side; bf16* VF; bf16* KF; bf16* IKF;
    __device__ __forceinline__ void operator()(const pg8::f32x4 (&acc)[2][2][4][2], const pg8::Unit& u, int wr, int wc, int fr, int fq) const {
        const int row0 = u.pm * 256 + wr * 64 + fr, col0 = u.pn * 256 + wc * 32 + 8 * fq;
        const bool last = (u.pn == 22);
        const bool sidew = last && (wc == 2) && (fq < 3);
#pragma unroll
        for (int ai = 0; ai < 2; ++ai)
#pragma unroll
            for (int m = 0; m < 4; ++m) {
                const int row = row0 + ai * 128 + m * 16;
                bf16* rowp = P + (size_t)row * PP + col0;
                const int bb = row >> 11, t = row & 2047;
#pragma unroll
                for (int bj = 0; bj < 2; ++bj) {
                    const pg8::f32x4 v0 = acc[ai][bj][m][0], v1 = acc[ai][bj][m][1];
                    u32x4 w; w.x = pg8::cvt_pk_bf16(v0[0], v0[1]); w.y = pg8::cvt_pk_bf16(v0[2], v0[3]); w.z = pg8::cvt_pk_bf16(v1[0], v1[1]); w.w = pg8::cvt_pk_bf16(v1[2], v1[3]);
                    *(u32x4*)(rowp + bj * 128) = w;
                    if (last) {
                        if (bj == 1 && sidew) { float* sp = side + (size_t)row * 32 + 8 * fq; *(pg8::f32x4*)sp = v0; *(pg8::f32x4*)(sp + 4) = v1; }
                        if (wc < 2) {
                            if (bj == 0) *(u32x4*)(KF + ((((size_t)(bb * 64 + (t >> 5)) * 2 + ((t >> 4) & 1)) * 2 + wc) * 64 + fq * 16 + (t & 15)) * 8) = w;
                            else *(u32x4*)(IKF + (((size_t)(bb * 128 + (t >> 4)) * 2 + wc) * 64 + fq * 16 + (t & 15)) * 8) = w;
                        } else if (bj == 0) {
                            const int kk32 = t & 31;
                            bf16* vp = VF + ((((size_t)(bb * 64 + (t >> 5)) * 4 + (wc - 2) * 2 + (fq >> 1)) * 64 + ((kk32 & 15) >> 2) * 16 + 8 * (fq & 1)) * 8) + (kk32 >> 4) * 4 + (kk32 & 3);
#pragma unroll
                            for (int e = 0; e < 4; ++e) { vp[e * 8] = (bf16)f2bf(v0[e]); vp[(4 + e) * 8] = (bf16)f2bf(v1[e]); }
                        }
                    }
                }
            }
    }
};
struct EpiOut {
    static constexpr bool PERM = false, AFTER_DRAIN = false;
    const float* base; float* out;
    __device__ __forceinline__ void operator()(const pg8::f32x4 (&acc)[2][2][4][2], const pg8::Unit& u, int wr, int wc, int fr, int fq) const {
        const int col0 = u.pn * 256 + wc * 32 + 4 * fq;
#pragma unroll
        for (int ai = 0; ai < 2; ++ai)
#pragma unroll
            for (int m = 0; m < 4; ++m) {
                const int r = u.pm * 256 + ai * 128 + wr * 64 + m * 16 + fr; const size_t off = (size_t)r * D_MODEL + col0;
#pragma unroll
                for (int bj = 0; bj < 2; ++bj)
#pragma unroll
                    for (int n = 0; n < 2; ++n) { const pg8::f32x4 bs = *(const pg8::f32x4*)(base + off + bj * 128 + n * 16); *(pg8::f32x4*)(out + off + bj * 128 + n * 16) = bs + acc[ai][bj][m][n]; }
            }
    }
};
struct EpiGlu {
    static constexpr bool PERM = true, AFTER_DRAIN = false;
    const bf16* yg; const bf16* proj; const float* gb; bf16* mix;
    __device__ __forceinline__ void operator()(const pg8::f32x4 (&acc)[2][2][4][2], const pg8::Unit& u, int wr, int wc, int fr, int fq) const {
        const int row0 = u.pm * 256 + wr * 64 + fr, col0 = u.pn * 256 + wc * 32 + 8 * fq;
#pragma unroll
        for (int ai = 0; ai < 2; ++ai)
#pragma unroll
            for (int m = 0; m < 4; ++m) {
                const int row = row0 + ai * 128 + m * 16;
#pragma unroll
                for (int bj = 0; bj < 2; ++bj) {
                    const int c = col0 + bj * 128;
                    float y[8], z[8], o[8];
                    unpack8(*(const u32x4*)(yg + (size_t)row * 512 + c), y);
                    unpack8(*(const u32x4*)(proj + (size_t)row * PP + P_S5Z + c), z);
                    const pg8::f32x4 b0 = *(const pg8::f32x4*)(gb + c), b1 = *(const pg8::f32x4*)(gb + c + 4);
                    const pg8::f32x4 v0 = acc[ai][bj][m][0] + b0, v1 = acc[ai][bj][m][1] + b1;
#pragma unroll
                    for (int j = 0; j < 4; ++j) { o[j] = y[j] * sigmoidf_(v0[j]) * siluf(z[j]); o[4 + j] = y[4 + j] * sigmoidf_(v1[j]) * siluf(z[4 + j]); }
                    u32x4 w; w.x = pk2(o[0], o[1]); w.y = pk2(o[2], o[3]); w.z = pk2(o[4], o[5]); w.w = pk2(o[6], o[7]);
                    *(u32x4*)(mix + (size_t)row * D_MODEL + MX_S5 + c) = w;
                }
            }
    }
};

__device__ __forceinline__ int win_src_col(int n) {
    if (n < 4096) return n;
    if (n < 4608) return n - 4096 + 4112;
    if (n < 5120) return n - 4608 + 4752;
    if (n < 5632) return n - 5120 + 5336;
    if (n < 5696) return n - 5632 + 4624;
    if (n < 5760) return n - 5696 + 4688;
    if (n < 5824) return n - 5760 + 5264;
    if (n < 5840) return n - 5824 + 4096;
    if (n < 5848) return n - 5840 + 5328;
    return -1;
}
template <int MODE>
__device__ __forceinline__ void transpose_item(const float* W, int K, int Nsrc, bf16* WT, float* scr, int kb, int nb, int lane) {
    const int k0 = 64 * kb, n0 = 32 * nb;
    const int nsrc = (MODE == 1) ? win_src_col(n0 + (lane & 31)) : (n0 + (lane & 31));
#pragma unroll 8
    for (int i = 0; i < 32; ++i) { const int kk = 2 * i + (lane >> 5); scr[kk * 33 + (lane & 31)] = (nsrc >= 0) ? W[(size_t)(k0 + kk) * Nsrc + nsrc] : 0.f; }
    asm volatile("s_waitcnt lgkmcnt(0)" ::: "memory");
    const int c = lane & 7;
#pragma unroll
    for (int j = 0; j < 4; ++j) { const int n = (lane >> 3) + 8 * j; const float* s = scr + (8 * c) * 33 + n;
        u32x4 o; o.x = pk2(s[0 * 33], s[1 * 33]); o.y = pk2(s[2 * 33], s[3 * 33]); o.z = pk2(s[4 * 33], s[5 * 33]); o.w = pk2(s[6 * 33], s[7 * 33]);
        *(u32x4*)(WT + (size_t)(n0 + n) * K + k0 + 8 * c) = o; }
    asm volatile("s_waitcnt lgkmcnt(0)" ::: "memory");
}

constexpr size_t S5P_LAM = 0, S5P_BBT = 64 * 1024, S5P_CT = 64 * 1024 + 256 * 1024;
__device__ __forceinline__ void phase_s5_params(const Args& a) {
    float* lam = (float*)(a.ws + WS_S5P + S5P_LAM);
    bf16* BBT = (bf16*)(a.ws + WS_S5P + S5P_BBT);
    bf16* CT = (bf16*)(a.ws + WS_S5P + S5P_CT);
    const int gt = obid() * 512 + otid();
    if (gt >= 2 * 32 * 64) return;
    const int l = gt / 2048, g = (gt / 64) % 32, p = gt % 64;
    const float A_re = a.in[3][gt], A_im = a.in[4][gt];
    const float dt = expf(a.in[5][l * 32 + g]);
    const float lre = fminf(A_re, -1e-4f), lim = A_im;
    const float mag = expf(lre * dt);
    const float lbr = mag * cosf(lim * dt), lbi = mag * sinf(lim * dt);
    const float nr = lbr - 1.0f, ni = lbi;
    const float den = lre * lre + lim * lim;
    const float fr = (nr * lre + ni * lim) / den, fi = (ni * lre - nr * lim) / den;
    lam[gt * 2] = lbr; lam[gt * 2 + 1] = lbi;
    for (int c = 0; c < 16; ++c) {
        const float Bre = a.in[6][gt * 16 + c], Bim = a.in[7][gt * 16 + c];
        BBT[((size_t)(l * 32 + g) * 128 + p) * 16 + c] = (bf16)f2bf(fr * Bre - fi * Bim);
        BBT[((size_t)(l * 32 + g) * 128 + 64 + p) * 16 + c] = (bf16)f2bf(fr * Bim + fi * Bre);
        CT[((size_t)(l * 32 + g) * 16 + c) * 128 + p] = (bf16)f2bf(a.in[8][((size_t)(l * 32 + g) * 16 + c) * 64 + p]);
        CT[((size_t)(l * 32 + g) * 16 + c) * 128 + 64 + p] = (bf16)f2bf(-a.in[9][((size_t)(l * 32 + g) * 16 + c) * 64 + p]);
    }
}

__device__ __forceinline__ void phase_rmsnorm_bf16(const float* X, const float* w, bf16* XB) {
    const int wave = otid() >> 6, lane = otid() & 63;
    const int nw = blockDim.x >> 6;
    for (int row = obid() * nw + wave; row < M_TOK; row += gridDim.x * nw) {
        const float4* xr = (const float4*)(X + (size_t)row * D_MODEL);
        float4 v[8]; float s = 0.f;
#pragma unroll
        for (int j = 0; j < 8; ++j) { v[j] = xr[lane + 64 * j]; s += v[j].x * v[j].x + v[j].y * v[j].y + v[j].z * v[j].z + v[j].w * v[j].w; }
        s = wave_sum(s);
        const float rs = 1.0f / sqrtf(s * (1.0f / D_MODEL) + EPS);
        u32x2* hr = (u32x2*)(XB + (size_t)row * D_MODEL);
#pragma unroll
        for (int j = 0; j < 8; ++j) { const float4 ww = ((const float4*)w)[lane + 64 * j];
            u32x2 o; o.x = pk2(v[j].x * rs * ww.x, v[j].y * rs * ww.y); o.y = pk2(v[j].z * rs * ww.z, v[j].w * rs * ww.w); hr[lane + 64 * j] = o; }
    }
}
__device__ __forceinline__ void phase_rmsnorm_f32(const float* X, const float* w, float* H) {
    const int wave = otid() >> 6, lane = otid() & 63;
    const int nw = blockDim.x >> 6;
    for (int row = obid() * nw + wave; row < M_TOK; row += gridDim.x * nw) {
        const float4* xr = (const float4*)(X + (size_t)row * D_MODEL);
        float4 v[8]; float s = 0.f;
#pragma unroll
        for (int j = 0; j < 8; ++j) { v[j] = xr[lane + 64 * j]; s += v[j].x * v[j].x + v[j].y * v[j].y + v[j].z * v[j].z + v[j].w * v[j].w; }
        s = wave_sum(s);
        const float rs = 1.0f / sqrtf(s * (1.0f / D_MODEL) + EPS);
        float4* hr = (float4*)(H + (size_t)row * D_MODEL);
#pragma unroll
        for (int j = 0; j < 8; ++j) { const float4 ww = ((const float4*)w)[lane + 64 * j];
            float4 o; o.x = v[j].x * rs * ww.x; o.y = v[j].y * rs * ww.y; o.z = v[j].z * rs * ww.z; o.w = v[j].w * rs * ww.w; hr[lane + 64 * j] = o; }
    }
}

__device__ __forceinline__ void phase_prologue(const Args& a, float* smem) {
    const int wave = otid() >> 6, lane = otid() & 63;
    float* scr = smem + wave * 4096;
    const int gw = obid() * 8 + wave, NGW = gridDim.x * 8;
    constexpr int I_IN = 32 * (PP / 32), I_OUT = 32 * 64, I_GLU = 8 * 16;
    constexpr int NIT = 2 * (I_IN + I_OUT + I_GLU);
    for (int it = gw; it < NIT; it += NGW) {
        int r = it; const int l = r / (I_IN + I_OUT + I_GLU); r -= l * (I_IN + I_OUT + I_GLU);
        if (r < I_IN) { transpose_item<1>(a.in[2] + (size_t)l * D_MODEL * D_IN, 2048, D_IN, (bf16*)(a.ws + WS_WIN + l * WIN_L), scr, r / (PP / 32), r % (PP / 32), lane); continue; }
        r -= I_IN;
        if (r < I_OUT) { transpose_item<0>(a.in[20] + (size_t)l * D_MODEL * D_MODEL, 2048, 2048, (bf16*)(a.ws + WS_WOUT + l * WOUT_L), scr, r / 64, r % 64, lane); continue; }
        r -= I_OUT;
        transpose_item<0>(a.in[11] + (size_t)l * 512 * 512, 512, 512, (bf16*)(a.ws + WS_WGLU + l * WGLU_L), scr, r / 16, r % 16, lane);
    }
    phase_s5_params(a);
    phase_rmsnorm_bf16(a.in[0], a.in[1], (bf16*)(a.ws + WS_XB));
}

typedef short bf16x8 __attribute__((ext_vector_type(8)));
typedef float f32x16 __attribute__((ext_vector_type(16)));
#define MFMA32(a, b, c) __builtin_amdgcn_mfma_f32_32x32x16_bf16((a), (b), (c), 0, 0, 0)
#define MFMA16(a, b, c) __builtin_amdgcn_mfma_f32_16x16x32_bf16((a), (b), (c), 0, 0, 0)
__device__ __forceinline__ int crow(int r, int hh) { return (r & 3) + 8 * (r >> 2) + 4 * hh; }
__device__ __forceinline__ bf16x8 ld16(const bf16* p) { return *(const bf16x8*)p; }
__device__ __forceinline__ bf16x8 ld8x2(const bf16* p0, const bf16* p1) { const u32x2 x = *(const u32x2*)p0, y = *(const u32x2*)p1; const u32x4 v = {x.x, x.y, y.x, y.y}; return __builtin_bit_cast(bf16x8, v); }
__device__ __forceinline__ f32x16 zero16() { f32x16 z;
#pragma unroll
    for (int i = 0; i < 16; ++i) z[i] = 0.f; return z; }

template <bool OUT>
__device__ __forceinline__ void s5_tile(const bf16* proj, bf16* yg, float* T, size_t row0, int g, int lane, const bf16x8 (&bb)[4], const bf16x8 (&ct)[4], float ar, float ai, float dd, float& xr, float& xi) {
    const int r = lane & 31, hh = lane >> 5, cc = lane & 15, q4 = lane >> 4;
    const bf16x8 uf = ld16(proj + (row0 + r) * PP + P_S5U + g * 16 + 8 * hh);
#pragma unroll
    for (int nb = 0; nb < 4; ++nb) {
        const f32x16 acc = MFMA32(uf, bb[nb], zero16());
#pragma unroll
        for (int rg = 0; rg < 16; ++rg) T[crow(rg, hh) * 132 + nb * 32 + r] = acc[rg];
    }
    asm volatile("s_waitcnt lgkmcnt(0)" ::: "memory");
#pragma unroll 8
    for (int t = 0; t < 32; ++t) {
        const float bur = T[t * 132 + lane], bui = T[t * 132 + 64 + lane];
        const float nxr = fmaf(ar, xr, fmaf(-ai, xi, bur));
        const float nxi = fmaf(ar, xi, fmaf(ai, xr, bui));
        xr = nxr; xi = nxi;
        if (OUT) { T[t * 132 + lane] = xr; T[t * 132 + 64 + lane] = xi; }
    }
    if (OUT) {
        asm volatile("s_waitcnt lgkmcnt(0)" ::: "memory");
#pragma unroll
        for (int mt = 0; mt < 2; ++mt) {
            f32x4 y = {0.f, 0.f, 0.f, 0.f};
#pragma unroll
            for (int kk = 0; kk < 4; ++kk) {
                const float* tp = T + (mt * 16 + cc) * 132 + kk * 32 + 8 * q4;
                const float4 f0 = *(const float4*)tp, f1 = *(const float4*)(tp + 4);
                u32x4 av; av.x = pk2(f0.x, f0.y); av.y = pk2(f0.z, f0.w); av.z = pk2(f1.x, f1.y); av.w = pk2(f1.z, f1.w);
                y = MFMA16(__builtin_bit_cast(bf16x8, av), ct[kk], y);
            }
#pragma unroll
            for (int rg = 0; rg < 4; ++rg) {
                const size_t row = row0 + mt * 16 + q4 * 4 + rg;
                const float ul = bf2f(proj[row * PP + P_S5U + g * 16 + cc]);
                yg[row * 512 + g * 16 + cc] = (bf16)f2bf(gelu_tanh(y[rg] + dd * ul));
            }
        }
    }
    asm volatile("s_waitcnt lgkmcnt(0)" ::: "memory");
}

__device__ __forceinline__ void phase_s5(const Args& a, int l, float* smem) {
    const bf16* proj = (const bf16*)(a.ws + WS_PROJ);
    bf16* yg = (bf16*)(a.ws + WS_YG);
    const float* lam = (const float*)(a.ws + WS_S5P + S5P_LAM) + (size_t)l * 32 * 64 * 2;
    const bf16* BBT = (const bf16*)(a.ws + WS_S5P + S5P_BBT) + (size_t)l * 32 * 128 * 16;
    const bf16* CT = (const bf16*)(a.ws + WS_S5P + S5P_CT) + (size_t)l * 32 * 16 * 128;
    const float* Dp = a.in[10] + (size_t)l * 512;
    const int tid = otid(), wave = tid >> 6, lane = tid & 63, r = lane & 31, hh = lane >> 5, cc = lane & 15, q4 = lane >> 4;
    float* T = smem + wave * 4224;
    float* segend = smem + 8 * 4224;
    for (int unit = obid(); unit < BATCH * 32; unit += gridDim.x) {
        const int b = unit >> 5, g = unit & 31;
        const float ar = lam[(g * 64 + lane) * 2], ai = lam[(g * 64 + lane) * 2 + 1];
        bf16x8 bb[4], ct[4];
#pragma unroll
        for (int nb = 0; nb < 4; ++nb) bb[nb] = ld16(BBT + ((size_t)(g * 128 + nb * 32 + r)) * 16 + 8 * hh);
#pragma unroll
        for (int kk = 0; kk < 4; ++kk) ct[kk] = ld16(CT + ((size_t)(g * 16 + cc)) * 128 + kk * 32 + 8 * q4);
        const float dd = Dp[g * 16 + cc];
        __syncthreads();
        float xr = 0.f, xi = 0.f;
        const size_t rowb = (size_t)b * SEQ + wave * 256;
#pragma unroll 1
        for (int tile = 0; tile < 8; ++tile) s5_tile<false>(proj, yg, T, rowb + tile * 32, g, lane, bb, ct, ar, ai, dd, xr, xi);
        segend[wave * 128 + lane] = xr; segend[wave * 128 + 64 + lane] = xi;
        __syncthreads();
        float pr = ar, pi = ai;
#pragma unroll
        for (int i = 0; i < 8; ++i) { const float t = pr * pr - pi * pi; pi = 2.f * pr * pi; pr = t; }
        float cr = 0.f, ci = 0.f;
        for (int w2 = 0; w2 < wave; ++w2) { const float sr = segend[w2 * 128 + lane], si = segend[w2 * 128 + 64 + lane]; const float t = pr * cr - pi * ci + sr; ci = pr * ci + pi * cr + si; cr = t; }
        xr = cr; xi = ci;
#pragma unroll 1
        for (int tile = 0; tile < 8; ++tile) s5_tile<true>(proj, yg, T, rowb + tile * 32, g, lane, bb, ct, ar, ai, dd, xr, xi);
    }
}


__device__ __forceinline__ void phase_ssd_pre(const Args& a, int l, float* smem) {
    const bf16* proj = (const bf16*)(a.ws + WS_PROJ);
    const float* side = (const float*)(a.ws + WS_SIDE);
    float* DTS = (float*)(a.ws + WS_DTS); float* CS = (float*)(a.ws + WS_CS);
    bf16* XC = (bf16*)(a.ws + WS_XC); bf16* XT1 = (bf16*)(a.ws + WS_XT1); bf16* XT2 = (bf16*)(a.ws + WS_XT2); bf16* BTR = (bf16*)(a.ws + WS_BTR);
    const float* cw = a.in[13] + (size_t)l * 4 * 2048;
    const float* cb = a.in[14] + (size_t)l * 2048;
    float* dtl = smem; float* csl = smem + 1024;
    const int tid = otid(), wave = tid >> 6, lane = tid & 63;
    for (int u = obid(); u < 512; u += gridDim.x) {
        const int b = u >> 7, c = (u >> 2) & 31, q = u & 3;
        const size_t row0 = (size_t)b * SEQ + c * 64;
        __syncthreads();
#pragma unroll
        for (int k = 0; k < 2; ++k) {
            const int h = wave * 2 + k;
            const float dtv = softplusf_(side[(row0 + lane) * 32 + h] + a.in[15][l * 16 + h]);
            float v = dtv * (-expf(a.in[16][l * 16 + h]));
#pragma unroll
            for (int o = 1; o < 64; o <<= 1) { const float t = __shfl_up(v, o); if (lane >= o) v += t; }
            dtl[lane * 16 + h] = dtv; csl[lane * 16 + h] = v;
            if (q == 0) { DTS[(row0 + lane) * 16 + h] = dtv; CS[(row0 + lane) * 16 + h] = v; }
        }
        __syncthreads();
        const int cp = tid & 255, th = tid >> 8, ch = q * 512 + 2 * cp;
        float w0[4], w1[4];
#pragma unroll
        for (int k = 0; k < 4; ++k) { w0[k] = cw[k * 2048 + ch]; w1[k] = cw[k * 2048 + ch + 1]; }
        const float b0 = cb[ch], b1 = cb[ch + 1];
        const bf16* pcol = proj + P_XBC + ch;
        float xa[11], xb[11];
#pragma unroll
        for (int i = 0; i < 3; ++i) {
            const int t = th * 32 - 3 + i;
            unsigned v = 0u; if (c * 64 + t >= 0) v = *(const unsigned*)(pcol + (row0 + t) * PP);
            xa[i] = __uint_as_float(v << 16); xb[i] = __uint_as_float(v & 0xffff0000u);
        }
        const int hx = ch >> 6;
#pragma unroll 1
        for (int grp = 0; grp < 4; ++grp) {
            const int t0 = th * 32 + grp * 8;
#pragma unroll
            for (int i = 0; i < 8; ++i) { const unsigned v = *(const unsigned*)(pcol + (row0 + t0 + i) * PP); xa[3 + i] = __uint_as_float(v << 16); xb[3 + i] = __uint_as_float(v & 0xffff0000u); }
            float ya[8], yb[8];
#pragma unroll
            for (int i = 0; i < 8; ++i) {
                float s0 = b0, s1 = b1;
#pragma unroll
                for (int k = 0; k < 4; ++k) { s0 = fmaf(w0[k], xa[i + k], s0); s1 = fmaf(w1[k], xb[i + k], s1); }
                ya[i] = siluf(s0); yb[i] = siluf(s1);
                *(unsigned*)(XC + (row0 + t0 + i) * 2048 + ch) = pk2(ya[i], yb[i]);
            }
            if (q < 2) {
                bf16* d1 = XT1 + ((size_t)b * 1024 + ch) * 2048 + c * 64 + t0;
                bf16* d2 = XT2 + ((size_t)b * 1024 + ch) * 2048 + c * 64 + t0;
                u32x4 o; o.x = pk2(ya[0], ya[1]); o.y = pk2(ya[2], ya[3]); o.z = pk2(ya[4], ya[5]); o.w = pk2(ya[6], ya[7]); *(u32x4*)d1 = o;
                o.x = pk2(yb[0], yb[1]); o.y = pk2(yb[2], yb[3]); o.z = pk2(yb[4], yb[5]); o.w = pk2(yb[6], yb[7]); *(u32x4*)(d1 + 2048) = o;
                float wg[8]; const float cend = csl[63 * 16 + hx];
#pragma unroll
                for (int i = 0; i < 8; ++i) wg[i] = dtl[(t0 + i) * 16 + hx] * expf(cend - csl[(t0 + i) * 16 + hx]);
                o.x = pk2(ya[0] * wg[0], ya[1] * wg[1]); o.y = pk2(ya[2] * wg[2], ya[3] * wg[3]); o.z = pk2(ya[4] * wg[4], ya[5] * wg[5]); o.w = pk2(ya[6] * wg[6], ya[7] * wg[7]); *(u32x4*)d2 = o;
                o.x = pk2(yb[0] * wg[0], yb[1] * wg[1]); o.y = pk2(yb[2] * wg[2], yb[3] * wg[3]); o.z = pk2(yb[4] * wg[4], yb[5] * wg[5]); o.w = pk2(yb[6] * wg[6], yb[7] * wg[7]); *(u32x4*)(d2 + 2048) = o;
            } else if (q == 2) {
                bf16* d1 = BTR + ((size_t)b * 512 + (ch - 1024)) * 2048 + c * 64 + t0;
                u32x4 o; o.x = pk2(ya[0], ya[1]); o.y = pk2(ya[2], ya[3]); o.z = pk2(ya[4], ya[5]); o.w = pk2(ya[6], ya[7]); *(u32x4*)d1 = o;
                o.x = pk2(yb[0], yb[1]); o.y = pk2(yb[2], yb[3]); o.z = pk2(yb[4], yb[5]); o.w = pk2(yb[6], yb[7]); *(u32x4*)(d1 + 2048) = o;
            }
#pragma unroll
            for (int i = 0; i < 3; ++i) { xa[i] = xa[8 + i]; xb[i] = xb[8 + i]; }
        }
    }
}

__device__ __forceinline__ void phase_ssd1(const Args& a) {
    const bf16* XT2 = (const bf16*)(a.ws + WS_XT2); const bf16* BTR = (const bf16*)(a.ws + WS_BTR); bf16* CST = (bf16*)(a.ws + WS_CST);
    const int tid = otid(), wave = tid >> 6, lane = tid & 63, r = lane & 31, hh = lane >> 5;
    for (int u = obid() * 8 + wave; u < 2048; u += gridDim.x * 8) {
        const int b = u >> 9, c = (u >> 4) & 31, h = u & 15, g = h >> 2;
        bf16x8 af[2][4];
#pragma unroll
        for (int pb = 0; pb < 2; ++pb)
#pragma unroll
            for (int kk = 0; kk < 4; ++kk) af[pb][kk] = ld16(XT2 + ((size_t)b * 1024 + h * 64 + pb * 32 + r) * 2048 + c * 64 + kk * 16 + 8 * hh);
        bf16* outb = CST + ((size_t)((b * 32 + c) * 16 + h)) * 64 * 128;
#pragma unroll 1
        for (int nb = 0; nb < 4; ++nb) {
            bf16x8 bfr[4];
#pragma unroll
            for (int kk = 0; kk < 4; ++kk) bfr[kk] = ld16(BTR + ((size_t)b * 512 + g * 128 + nb * 32 + r) * 2048 + c * 64 + kk * 16 + 8 * hh);
#pragma unroll
            for (int pb = 0; pb < 2; ++pb) {
                f32x16 acc = zero16();
#pragma unroll
                for (int kk = 0; kk < 4; ++kk) acc = MFMA32(af[pb][kk], bfr[kk], acc);
#pragma unroll
                for (int rg = 0; rg < 16; ++rg) outb[(pb * 32 + crow(rg, hh)) * 128 + nb * 32 + r] = (bf16)f2bf(acc[rg]);
            }
        }
    }
}

__device__ __forceinline__ void phase_ssd2(const Args& a) {
    const float* CS = (const float*)(a.ws + WS_CS); bf16* CST = (bf16*)(a.ws + WS_CST);
    for (int e = obid() * 512 + otid(); e < 4 * 16 * 64 * 32; e += gridDim.x * 512) {
        const int b = e >> 15, h = (e >> 11) & 15, pn = e & 2047;
        float st0 = 0.f, st1 = 0.f, st2 = 0.f, st3 = 0.f;
        u32x2* ptr = (u32x2*)(CST + ((size_t)(b * 32 * 16 + h)) * 8192 + (size_t)pn * 4);
        u32x2 nxt = *ptr;
#pragma unroll 1
        for (int c = 0; c < 32; ++c) {
            const u32x2 cur = nxt;
            if (c + 1 < 32) nxt = *(ptr + (size_t)(c + 1) * 16 * 8192 / 4);
            const float dec = expf(CS[((size_t)b * SEQ + c * 64 + 63) * 16 + h]);
            u32x2 o; o.x = pk2(st0, st1); o.y = pk2(st2, st3);
            *(ptr + (size_t)c * 16 * 8192 / 4) = o;
            st0 = fmaf(st0, dec, __uint_as_float(cur.x << 16)); st1 = fmaf(st1, dec, __uint_as_float(cur.x & 0xffff0000u));
            st2 = fmaf(st2, dec, __uint_as_float(cur.y << 16)); st3 = fmaf(st3, dec, __uint_as_float(cur.y & 0xffff0000u));
        }
    }
}

__device__ __forceinline__ void phase_ssd3(const Args& a, int l, float* smem) {
    const bf16* proj = (const bf16*)(a.ws + WS_PROJ);
    const bf16* XC = (const bf16*)(a.ws + WS_XC); const bf16* XT1 = (const bf16*)(a.ws + WS_XT1); const bf16* PREV = (const bf16*)(a.ws + WS_CST);
    const float* DTS = (const float*)(a.ws + WS_DTS); const float* CS = (const float*)(a.ws + WS_CS);
    float* SSQ = (float*)(a.ws + WS_SSQ); bf16* mix = (bf16*)(a.ws + WS_MIX);
    const int tid = otid(), wave = tid >> 6, lane = tid & 63, r = lane & 31, hh = lane >> 5;
    float* ybuf = smem + wave * 4480;
    float* csl = ybuf + 64 * 68; float* dtl = csl + 64;
    for (int u = obid() * 8 + wave; u < 2048; u += gridDim.x * 8) {
        const int b = u >> 9, c = (u >> 4) & 31, h = u & 15, g = h >> 2;
        const size_t row0 = (size_t)b * SEQ + c * 64;
        csl[lane] = CS[(row0 + lane) * 16 + h]; dtl[lane] = DTS[(row0 + lane) * 16 + h];
        asm volatile("s_waitcnt lgkmcnt(0)" ::: "memory");
        const float Dh = a.in[17][l * 16 + h];
        const bf16* prevb = PREV + ((size_t)((b * 32 + c) * 16 + h)) * 64 * 128;
#pragma unroll 1
        for (int lb = 0; lb < 2; ++lb) {
            bf16x8 cf[8];
#pragma unroll
            for (int kk = 0; kk < 8; ++kk) cf[kk] = ld16(XC + (row0 + lb * 32 + r) * 2048 + 1536 + g * 128 + kk * 16 + 8 * hh);
            f32x16 yo[2]; yo[0] = zero16(); yo[1] = zero16();
#pragma unroll
            for (int pb = 0; pb < 2; ++pb)
#pragma unroll
                for (int kk = 0; kk < 8; ++kk) { const bf16x8 pf = ld16(prevb + (pb * 32 + r) * 128 + kk * 16 + 8 * hh); yo[pb] = MFMA32(pf, cf[kk], yo[pb]); }
            const float csL = csl[lb * 32 + r];
            const float eL = expf(csL);
            f32x16 yd[2]; yd[0] = zero16(); yd[1] = zero16();
#pragma unroll 1
            for (int sb = 0; sb <= lb; ++sb) {
                f32x16 gt = zero16();
#pragma unroll
                for (int kk = 0; kk < 8; ++kk) { const bf16x8 bfm = ld16(XC + (row0 + sb * 32 + r) * 2048 + 1024 + g * 128 + kk * 16 + 8 * hh); gt = MFMA32(bfm, cf[kk], gt); }
                const int lcol = lb * 32 + r;
#pragma unroll
                for (int rg = 0; rg < 16; ++rg) { const int sidx = sb * 32 + crow(rg, hh); const float v = gt[rg] * expf(fminf(csL - csl[sidx], 0.f)) * dtl[sidx]; gt[rg] = (sidx <= lcol) ? v : 0.f; }
#pragma unroll
                for (int s16 = 0; s16 < 2; ++s16) {
                    u32x4 sv; sv.x = pk2(gt[8 * s16 + 0], gt[8 * s16 + 1]); sv.y = pk2(gt[8 * s16 + 2], gt[8 * s16 + 3]); sv.z = pk2(gt[8 * s16 + 4], gt[8 * s16 + 5]); sv.w = pk2(gt[8 * s16 + 6], gt[8 * s16 + 7]);
                    const bf16x8 sf = __builtin_bit_cast(bf16x8, sv);
#pragma unroll
                    for (int pb = 0; pb < 2; ++pb) {
                        const bf16* xp = XT1 + ((size_t)b * 1024 + h * 64 + pb * 32 + r) * 2048 + c * 64 + sb * 32 + 16 * s16 + 4 * hh;
                        const bf16x8 xf = ld8x2(xp, xp + 8);
                        yd[pb] = MFMA32(xf, sf, yd[pb]);
                    }
                }
            }
#pragma unroll
            for (int pb = 0; pb < 2; ++pb)
#pragma unroll
                for (int rg = 0; rg < 16; ++rg) ybuf[(lb * 32 + r) * 68 + pb * 32 + crow(rg, hh)] = yd[pb][rg] + eL * yo[pb][rg];
        }
        asm volatile("s_waitcnt lgkmcnt(0)" ::: "memory");
#pragma unroll 1
        for (int it = 0; it < 8; ++it) {
            const int lrow = it * 8 + (lane >> 3), p8 = (lane & 7) * 8;
            const size_t row = row0 + lrow;
            const float4 y0 = *(const float4*)(ybuf + lrow * 68 + p8), y1 = *(const float4*)(ybuf + lrow * 68 + p8 + 4);
            float x8[8], z8[8];
            unpack8(*(const u32x4*)(XC + row * 2048 + h * 64 + p8), x8);
            unpack8(*(const u32x4*)(proj + row * PP + P_SSDZ + h * 64 + p8), z8);
            const float yy[8] = {y0.x, y0.y, y0.z, y0.w, y1.x, y1.y, y1.z, y1.w};
            float o[8]; float ss = 0.f;
#pragma unroll
            for (int j = 0; j < 8; ++j) { o[j] = (yy[j] + Dh * x8[j]) * siluf(z8[j]); ss = fmaf(o[j], o[j], ss); }
            ss += __shfl_xor(ss, 1); ss += __shfl_xor(ss, 2); ss += __shfl_xor(ss, 4);
            if ((lane & 7) == 0) SSQ[row * 16 + h] = ss;
            u32x4 w; w.x = pk2(o[0], o[1]); w.y = pk2(o[2], o[3]); w.z = pk2(o[4], o[5]); w.w = pk2(o[6], o[7]);
            *(u32x4*)(mix + row * D_MODEL + MX_SSD + h * 64 + p8) = w;
        }
        asm volatile("s_waitcnt lgkmcnt(0)" ::: "memory");
    }
}

__device__ __forceinline__ void phase_ssd_norm(const Args& a, int l) {
    const float* SSQ = (const float*)(a.ws + WS_SSQ);
    bf16* mix = (bf16*)(a.ws + WS_MIX);
    const float* nwp = a.in[18] + (size_t)l * 1024;
    const int tid = otid(), wave = tid >> 6, lane = tid & 63;
    for (int row = obid() * 8 + wave; row < M_TOK; row += gridDim.x * 8) {
        float s = (lane < 16) ? SSQ[(size_t)row * 16 + lane] : 0.f;
        s = wave_sum(s);
        const float rs = 1.0f / sqrtf(s * (1.0f / 1024.f) + EPS);
#pragma unroll
        for (int j = 0; j < 2; ++j) {
            bf16* p = mix + (size_t)row * D_MODEL + MX_SSD + (lane + 64 * j) * 8;
            float v[8]; unpack8(*(const u32x4*)p, v);
            const float4 w0 = *(const float4*)(nwp + (lane + 64 * j) * 8), w1 = *(const float4*)(nwp + (lane + 64 * j) * 8 + 4);
            u32x4 o; o.x = pk2(v[0] * rs * w0.x, v[1] * rs * w0.y); o.y = pk2(v[2] * rs * w0.z, v[3] * rs * w0.w); o.z = pk2(v[4] * rs * w1.x, v[5] * rs * w1.y); o.w = pk2(v[6] * rs * w1.z, v[7] * rs * w1.w);
            *(u32x4*)p = o;
        }
    }
}

__device__ __forceinline__ int t5_bucket(int rel) {
    const int ret = rel > 0 ? 16 : 0; const int n = rel < 0 ? -rel : rel;
    if (n < 8) return ret + n;
    const int e = 31 - __clz(n);
    int v = 8 + 2 * (e - 3) + ((n * n) >= (1 << (2 * e + 1)) ? 1 : 0);
    return ret + (v < 15 ? v : 15);
}

__device__ __forceinline__ void phase_btab(const Args& a) {
    float* bt = (float*)(a.ws + WS_BTAB);
    for (int i = obid() * 512 + otid(); i < 8 * 4096; i += gridDim.x * 512) { const int h = i >> 12, rel = (i & 4095) - 2048; bt[i] = a.in[19][t5_bucket(rel) * 8 + h] * 1.4426950408889634f; }
}

typedef float f32x4v __attribute__((ext_vector_type(4)));
constexpr int SC_STRIDE = 2052;
__device__ __forceinline__ unsigned cvtpk(float lo, float hi) { unsigned r; asm("v_cvt_pk_bf16_f32 %0, %1, %2" : "=v"(r) : "v"(lo), "v"(hi)); return r; }
__device__ __forceinline__ float rows_max(float x) {
    auto r = __builtin_amdgcn_permlane32_swap(__float_as_uint(x), __float_as_uint(x), false, false); x = fmaxf(__uint_as_float(r[0]), __uint_as_float(r[1]));
    auto q = __builtin_amdgcn_permlane16_swap(__float_as_uint(x), __float_as_uint(x), false, false); return fmaxf(__uint_as_float(q[0]), __uint_as_float(q[1]));
}
__device__ __forceinline__ float rows_sum(float x) {
    auto r = __builtin_amdgcn_permlane32_swap(__float_as_uint(x), __float_as_uint(x), false, false); x = __uint_as_float(r[0]) + __uint_as_float(r[1]);
    auto q = __builtin_amdgcn_permlane16_swap(__float_as_uint(x), __float_as_uint(x), false, false); return __uint_as_float(q[0]) + __uint_as_float(q[1]);
}
__device__ __forceinline__ int wave_isum(int x) {
    x += __builtin_amdgcn_update_dpp(0, x, 0x111, 0xf, 0xf, true);
    x += __builtin_amdgcn_update_dpp(0, x, 0x112, 0xf, 0xf, true);
    x += __builtin_amdgcn_update_dpp(0, x, 0x114, 0xf, 0xf, true);
    x += __builtin_amdgcn_update_dpp(0, x, 0x118, 0xf, 0xf, true);
    x += __builtin_amdgcn_update_dpp(0, x, 0x142, 0xa, 0xf, false);
    x += __builtin_amdgcn_update_dpp(0, x, 0x143, 0xc, 0xf, false);
    return __builtin_amdgcn_readlane(x, 63);
}
__device__ __forceinline__ unsigned wave_umin(unsigned v) {
#pragma unroll
    for (int o = 1; o < 64; o <<= 1) { const unsigned t = (unsigned)__shfl_xor((int)v, o); v = t < v ? t : v; }
    return v;
}
__device__ __forceinline__ unsigned wave_umax(unsigned v) {
#pragma unroll
    for (int o = 1; o < 64; o <<= 1) { const unsigned t = (unsigned)__shfl_xor((int)v, o); v = t > v ? t : v; }
    return v;
}
template <int NW>
__device__ __forceinline__ void dsa_select2(const float* sc, unsigned long long* msk, int q0, int c, int lane) {
    unsigned ka[NW], kb[NW];
    unsigned mna = 0xffffffffu, mxa = 0u, mnb = 0xffffffffu, mxb = 0u;
#pragma unroll
    for (int r = 0; r < NW; ++r) {
        ka[r] = 0u; kb[r] = 0u;
        if (r <= c) {
            const unsigned ua = __float_as_uint(sc[q0 * SC_STRIDE + r * 64 + lane]), ub = __float_as_uint(sc[(q0 + 1) * SC_STRIDE + r * 64 + lane]);
            ka[r] = (ua & 0x80000000u) ? ~ua : (ua | 0x80000000u); kb[r] = (ub & 0x80000000u) ? ~ub : (ub | 0x80000000u);
            mna = ka[r] < mna ? ka[r] : mna; mxa = ka[r] > mxa ? ka[r] : mxa; mnb = kb[r] < mnb ? kb[r] : mnb; mxb = kb[r] > mxb ? kb[r] : mxb;
        }
    }
    unsigned loa = __builtin_amdgcn_readfirstlane(wave_umin(mna)), hia = __builtin_amdgcn_readfirstlane(wave_umax(mxa));
    unsigned lob = __builtin_amdgcn_readfirstlane(wave_umin(mnb)), hib = __builtin_amdgcn_readfirstlane(wave_umax(mxb));
    bool fa = (loa == hia), fb = (lob == hib), exa = false, exb = false;
    unsigned Ta = loa, Tb = lob;
    while (!(fa && fb)) {
        const unsigned da = hia - loa, db = hib - lob;
        const unsigned mida = loa + (da >> 1) + (da & 1u), midb = lob + (db >> 1) + (db & 1u);
        int cnt = 0;
#pragma unroll
        for (int r = 0; r < NW; ++r) { cnt += (ka[r] >= mida) ? 1 : 0; cnt += (kb[r] >= midb) ? 65536 : 0; }
        const int tot = wave_isum(cnt);
        const int ta = tot & 0xffff, tb = tot >> 16;
        if (!fa) { if (ta >= 256) loa = mida; else hia = mida - 1u; if (ta == 256) { fa = true; exa = true; Ta = mida; } else if (loa == hia) { fa = true; Ta = loa; } }
        if (!fb) { if (tb >= 256) lob = midb; else hib = midb - 1u; if (tb == 256) { fb = true; exb = true; Tb = midb; } else if (lob == hib) { fb = true; Tb = lob; } }
    }
#pragma unroll
    for (int qq = 0; qq < 2; ++qq) {
        const unsigned T = qq ? Tb : Ta; const bool ex = qq ? exb : exa;
        unsigned long long* mq = msk + (q0 + qq) * 32;
        if (ex) {
#pragma unroll
            for (int r = 0; r < NW; ++r) if (r <= c) { const unsigned long long m = __ballot((qq ? kb[r] : ka[r]) >= T); if (lane == 0) mq[r] = m; }
        } else {
            int cgt = 0;
#pragma unroll
            for (int r = 0; r < NW; ++r) cgt += ((qq ? kb[r] : ka[r]) > T) ? 1 : 0;
            int need = 256 - wave_isum(cgt);
#pragma unroll
            for (int r = 0; r < NW; ++r) if (r <= c) {
                const unsigned kv = qq ? kb[r] : ka[r];
                const unsigned long long gm = __ballot(kv > T); unsigned long long em = __ballot(kv == T);
                const int pc = __popcll(em);
                if (pc <= need) need -= pc;
                else { while (__popcll(em) > need) em &= ~(1ull << (63 - __clzll((long long)em))); need = 0; }
                if (lane == 0) mq[r] = gm | em;
            }
        }
    }
}
__device__ __forceinline__ void dsa_unit(const Args& a, int unit, float* smem) {
    const bf16* proj = (const bf16*)(a.ws + WS_PROJ);
    const float* side = (const float*)(a.ws + WS_SIDE);
    const bf16* VF = (const bf16*)(a.ws + WS_VF); const bf16* KF = (const bf16*)(a.ws + WS_KF); const bf16* IKF = (const bf16*)(a.ws + WS_IKF);
    const float* BT = (const float*)(a.ws + WS_BTAB);
    bf16* mix = (bf16*)(a.ws + WS_MIX);
    float* sc = smem;
    unsigned long long* msk = (unsigned long long*)(smem + 16 * SC_STRIDE);
    const int tid = otid(), wave = tid >> 6, lane = tid & 63, cc = lane & 15, q4 = lane >> 4;
    const int b = unit >> 7, q16 = unit & 127, c = q16 >> 2, nk = 64 * (c + 1);
    const int tq0 = q16 * 16;
    const size_t rowb = (size_t)b * SEQ, rowq = rowb + tq0;
    __syncthreads();
    {
        bf16x8 aq[8][2]; float wq[4][8];
#pragma unroll
        for (int h = 0; h < 8; ++h)
#pragma unroll
            for (int kk = 0; kk < 2; ++kk) aq[h][kk] = ld16(proj + (rowq + cc) * PP + P_IQ + h * 64 + kk * 32 + 8 * q4);
#pragma unroll
        for (int rg = 0; rg < 4; ++rg) {
            const float4 w0 = *(const float4*)(side + (rowq + q4 * 4 + rg) * 32 + 16), w1 = *(const float4*)(side + (rowq + q4 * 4 + rg) * 32 + 20);
            const float sc_ = 0.044194173824159216f;
            wq[rg][0] = w0.x * sc_; wq[rg][1] = w0.y * sc_; wq[rg][2] = w0.z * sc_; wq[rg][3] = w0.w * sc_; wq[rg][4] = w1.x * sc_; wq[rg][5] = w1.y * sc_; wq[rg][6] = w1.z * sc_; wq[rg][7] = w1.w * sc_;
        }
        const int nkb = 4 * (c + 1);
        const bf16* ikb = IKF + (size_t)b * 128 * 2 * 512 + lane * 8;
        bf16x8 nb0 = ld16(ikb + (size_t)wave * 1024), nb1 = ld16(ikb + (size_t)wave * 1024 + 512);
#pragma unroll 1
        for (int kb = wave; kb < nkb; kb += 8) {
            const int key0 = kb * 16;
            const bf16x8 bk0 = nb0, bk1 = nb1;
            { const int kn = (kb + 8 < nkb) ? kb + 8 : kb; nb0 = ld16(ikb + (size_t)kn * 1024); nb1 = ld16(ikb + (size_t)kn * 1024 + 512); }
            f32x4v s4 = {0.f, 0.f, 0.f, 0.f};
#pragma unroll
            for (int h = 0; h < 8; ++h) {
                f32x4v acc = {0.f, 0.f, 0.f, 0.f};
                acc = MFMA16(aq[h][0], bk0, acc); acc = MFMA16(aq[h][1], bk1, acc);
#pragma unroll
                for (int rg = 0; rg < 4; ++rg) s4[rg] = fmaf(fmaxf(acc[rg], 0.f), wq[rg][h], s4[rg]);
            }
#pragma unroll
            for (int rg = 0; rg < 4; ++rg) sc[(q4 * 4 + rg) * SC_STRIDE + key0 + cc] = s4[rg] + 0.0f;
        }
    }
    __syncthreads();
    if (nk <= 256) {
        if (lane <= c) { msk[(wave * 2) * 32 + lane] = ~0ull; msk[(wave * 2 + 1) * 32 + lane] = ~0ull; }
    } else if (c < 8) dsa_select2<8>(sc, msk, wave * 2, c, lane);
    else if (c < 16) dsa_select2<16>(sc, msk, wave * 2, c, lane);
    else if (c < 24) dsa_select2<24>(sc, msk, wave * 2, c, lane);
    else dsa_select2<32>(sc, msk, wave * 2, c, lane);
    __syncthreads();
    {
        const int h = wave;
        const bf16x8 bq0 = ld16(proj + (rowq + cc) * PP + P_AQ + h * 64 + 8 * q4), bq1 = ld16(proj + (rowq + cc) * PP + P_AQ + h * 64 + 32 + 8 * q4);
        f32x4v o[4];
#pragma unroll
        for (int dt = 0; dt < 4; ++dt) o[dt] = (f32x4v){0.f, 0.f, 0.f, 0.f};
        float m = -INFINITY, lsum = 0.f;
        const float* bbp = BT + h * 4096 + 2048 - (tq0 + cc) + q4 * 4;
        const int nst = 2 * (c + 1);
        const bf16* kfb = KF + (size_t)b * 64 * 2048 + lane * 8;
        const bf16* vfb = VF + (size_t)b * 64 * 2048 + lane * 8;
        const unsigned long long* mrow = msk + cc * 32;
        struct CSet { bf16x8 k00, k01, k10, k11, v0, v1, v2, v3; float4 ba, bb; };
#define DSA_LOAD(S, ks_) do { const bf16* kp_ = kfb + (size_t)(ks_) * 2048; const bf16* vp_ = vfb + (size_t)(ks_) * 2048; \
        S.k00 = ld16(kp_); S.k01 = ld16(kp_ + 512); S.k10 = ld16(kp_ + 1024); S.k11 = ld16(kp_ + 1536); \
        S.v0 = ld16(vp_); S.v1 = ld16(vp_ + 512); S.v2 = ld16(vp_ + 1024); S.v3 = ld16(vp_ + 1536); \
        S.ba = *(const float4*)(bbp + (ks_) * 32); S.bb = *(const float4*)(bbp + (ks_) * 32 + 16); asm volatile("" ::: "memory"); } while (0)
#define DSA_STEP(S, ks_) do { const int kbase_ = (ks_) * 32; \
        f32x4v s0 = {0.f, 0.f, 0.f, 0.f}, s1 = {0.f, 0.f, 0.f, 0.f}; \
        s0 = MFMA16(S.k00, bq0, s0); s0 = MFMA16(S.k01, bq1, s0); s1 = MFMA16(S.k10, bq0, s1); s1 = MFMA16(S.k11, bq1, s1); \
        const unsigned long long mw_ = mrow[kbase_ >> 6]; const unsigned bits_ = (unsigned)(mw_ >> ((kbase_ & 63) + q4 * 4)); \
        const float bia_[8] = {S.ba.x, S.ba.y, S.ba.z, S.ba.w, S.bb.x, S.bb.y, S.bb.z, S.bb.w}; \
        float lg_[8]; float mx_ = -INFINITY; \
        _Pragma("unroll") for (int rg = 0; rg < 4; ++rg) { \
            lg_[rg] = ((bits_ >> rg) & 1u) ? fmaf(s0[rg], 0.18033688011112042f, bia_[rg]) : -INFINITY; \
            lg_[4 + rg] = ((bits_ >> (16 + rg)) & 1u) ? fmaf(s1[rg], 0.18033688011112042f, bia_[4 + rg]) : -INFINITY; \
            mx_ = fmaxf(mx_, fmaxf(lg_[rg], lg_[4 + rg])); } \
        mx_ = rows_max(mx_); \
        if (__any(mx_ > m)) { const float mn_ = fmaxf(m, mx_); const float al_ = (mn_ == -INFINITY) ? 1.f : __builtin_amdgcn_exp2f(m - mn_); m = mn_; lsum *= al_; \
            _Pragma("unroll") for (int dt = 0; dt < 4; ++dt) o[dt] = o[dt] * al_; } \
        const float msub_ = (m == -INFINITY) ? 0.f : m; \
        float p_[8]; float ps_ = 0.f; \
        _Pragma("unroll") for (int jj = 0; jj < 8; ++jj) { p_[jj] = __builtin_amdgcn_exp2f(lg_[jj] - msub_); ps_ += p_[jj]; } \
        lsum += ps_; \
        u32x4 pv_; pv_.x = cvtpk(p_[0], p_[1]); pv_.y = cvtpk(p_[2], p_[3]); pv_.z = cvtpk(p_[4], p_[5]); pv_.w = cvtpk(p_[6], p_[7]); \
        const bf16x8 pf_ = __builtin_bit_cast(bf16x8, pv_); \
        o[0] = MFMA16(S.v0, pf_, o[0]); o[1] = MFMA16(S.v1, pf_, o[1]); o[2] = MFMA16(S.v2, pf_, o[2]); o[3] = MFMA16(S.v3, pf_, o[3]); } while (0)
        CSet SA, SB;
        DSA_LOAD(SA, 0);
#pragma unroll 1
        for (int ks = 0; ks < nst; ks += 2) {
            DSA_LOAD(SB, ks + 1);
            DSA_STEP(SA, ks);
            { const int kn = (ks + 2 < nst) ? ks + 2 : ks; DSA_LOAD(SA, kn); }
            DSA_STEP(SB, ks + 1);
        }
#undef DSA_LOAD
#undef DSA_STEP
        lsum = rows_sum(lsum);
        const float inv = 1.0f / lsum;
#pragma unroll
        for (int dt = 0; dt < 4; ++dt) {
            const int d0 = dt * 16 + q4 * 4;
            const float4 z = ldbf4(proj + (rowq + cc) * PP + P_AZ + h * 64 + d0);
            u32x2 w; w.x = pk2(o[dt][0] * inv * siluf(z.x), o[dt][1] * inv * siluf(z.y)); w.y = pk2(o[dt][2] * inv * siluf(z.z), o[dt][3] * inv * siluf(z.w));
            *(u32x2*)(mix + (rowq + cc) * D_MODEL + MX_ATT + h * 64 + d0) = w;
        }
    }
}
__device__ __forceinline__ void phase_dsa(const Args& a, int l, float* smem) {
    unsigned* ctr = (unsigned*)(a.ws + WS_CTL) + 15360 + 64 * l;
    volatile int* slot = (volatile int*)(smem + (147456 - 192) / 4);
    for (;;) {
        __syncthreads();
        if (otid() == 0) *slot = (int)__hip_atomic_fetch_add(ctr, 1u, __ATOMIC_RELAXED, __HIP_MEMORY_SCOPE_AGENT);
        __syncthreads();
        const int u = *slot;
        if (u >= 512) break;
        const int c = 31 - (u >> 4), r = u & 15;
        dsa_unit(a, (r >> 2) * 128 + c * 4 + (r & 3), smem);
    }
}

#define XB_TMO      128
#define XB_XCNT(j)  (256  + 64 * (j))
#define XB_XSUB(j)  (1280 + 64 * (j))
#define XB_XGEN(j)  (2304 + 64 * (j))
#define XB_TOP      3328
#define XB_TOPGEN   3392
#define XCD_BAR_WORDS 3456
#define XB_SPIN_CAP (1u << 18)

__device__ __forceinline__ unsigned xb_ld(unsigned* p)              { return __hip_atomic_load(p, __ATOMIC_RELAXED, __HIP_MEMORY_SCOPE_AGENT); }
__device__ __forceinline__ unsigned xb_add(unsigned* p, unsigned v) { return __hip_atomic_fetch_add(p, v, __ATOMIC_RELAXED, __HIP_MEMORY_SCOPE_AGENT); }
__device__ __forceinline__ unsigned xb_xcc_id() { return (unsigned)__builtin_amdgcn_s_getreg((3 << 11) | 20) & 0xFu; }
#define XB_SPIN(cond, bar) do { unsigned _sp = 0; while (cond) { __builtin_amdgcn_s_sleep(1); \
    if ((++_sp & 255u) == 0u) { if (xb_ld(&(bar)[XB_TMO])) break; if (_sp > XB_SPIN_CAP) { atomicAdd(&(bar)[XB_TMO], 1u); break; } } } } while (0)

struct XcdBarrier {
    unsigned* bar; unsigned x;
    volatile LAS unsigned* st;
};

__device__ __forceinline__ XcdBarrier xcd_barrier_post(unsigned* bar, volatile LAS unsigned* st) {
    XcdBarrier b; b.bar = bar; b.x = xb_xcc_id(); b.st = st;
    if (threadIdx.x == 0) (void)xb_add(&bar[XB_XCNT(b.x)], 1u);
    return b;
}
__device__ __forceinline__ void xcd_barrier_complete(unsigned* bar, unsigned x, unsigned& nloc, unsigned& nx) {
    const unsigned G = gridDim.x * gridDim.y * gridDim.z;
    unsigned sum, cnt, mine, sp = 0u;
    for (;;) {
        sum = 0u; cnt = 0u; mine = 0u;
#pragma unroll
        for (unsigned j = 0; j < 16; ++j) { const unsigned c = xb_ld(&bar[XB_XCNT(j)]); sum += c; cnt += (c > 0u) ? 1u : 0u; mine = (j == x) ? c : mine; }
        if (sum == G) break;
        __builtin_amdgcn_s_sleep(1);
        if ((++sp & 255u) == 0u) { if (xb_ld(&bar[XB_TMO])) break; if (sp > XB_SPIN_CAP) { atomicAdd(&bar[XB_TMO], 1u); break; } }
    }
    nloc = mine > 0u ? mine : 1u; nx = cnt > 0u ? cnt : 1u;
}

__device__ __forceinline__ void xcd_barrier(const XcdBarrier& b) {
    asm volatile("s_waitcnt vmcnt(0)" ::: "memory");
    __syncthreads();
    if (threadIdx.x == 0) {
        unsigned* bar = b.bar;
        __builtin_amdgcn_s_waitcnt(0);
        unsigned nloc = b.st[0], nx = b.st[1];
        if (nloc == 0u) { xcd_barrier_complete(bar, b.x, nloc, nx); b.st[0] = nloc; b.st[1] = nx; }
        const unsigned old = xb_add(&bar[XB_XSUB(b.x)], 1u);
        const unsigned gen = old / nloc;
        if (old + 1u == (gen + 1u) * nloc) {
            __builtin_amdgcn_fence(__ATOMIC_RELEASE, "agent");
            asm volatile("s_waitcnt vmcnt(0)" ::: "memory");
            const unsigned og = xb_add(&bar[XB_TOP], 1u);
            const unsigned tg = og / nx;
            if (og + 1u == (tg + 1u) * nx) xb_add(&bar[XB_TOPGEN], 1u);
            else XB_SPIN(xb_ld(&bar[XB_TOPGEN]) == tg, bar);
            __builtin_amdgcn_fence(__ATOMIC_ACQUIRE, "agent");
            xb_add(&bar[XB_XGEN(b.x)], 1u);
            asm volatile("s_waitcnt vmcnt(0)" ::: "memory");
        } else {
            XB_SPIN(xb_ld(&bar[XB_XGEN(b.x)]) == gen, bar);
            __builtin_amdgcn_fence(__ATOMIC_ACQUIRE, "agent");
            asm volatile("s_waitcnt vmcnt(0)" ::: "memory");
        }
    }
    __syncthreads();
}


constexpr int LDS_BYTES = 147456;
__global__ void __launch_bounds__(512, 2) mk_fwd(Args a) {
    extern __shared__ __attribute__((aligned(16))) unsigned char lds[];
    float* smem = (float*)lds;
    cg::grid_group grid = cg::this_grid();
    const int G = gridDim.x;
    volatile LAS unsigned* MISC = (volatile LAS unsigned*)((LAS unsigned char*)lds + (LDS_BYTES - 256));
    if (threadIdx.x < 64) MISC[threadIdx.x] = 0u;
    __syncthreads();
    XcdBarrier bar = xcd_barrier_post((unsigned*)(a.ws + WS_CTL) + 4096, MISC + 8);
    bf16* XB = (bf16*)(a.ws + WS_XB); bf16* PROJ = (bf16*)(a.ws + WS_PROJ); bf16* MIX = (bf16*)(a.ws + WS_MIX); bf16* YG = (bf16*)(a.ws + WS_YG);
    phase_prologue(a, smem);
    phase_btab(a);
    grid.sync();
    for (int l = 0; l < DEPTH; ++l) {
        const float* xcur = (l == 0) ? a.in[0] : a.out;
        {
            pg8::Gemm g{XB, (const bf16*)(a.ws + WS_WIN + l * WIN_L), M_TOK, PP, D_MODEL}; pg8::StaticOrder S; S.init(M_TOK, PP, G, obid());
            EpiProj E{PROJ, (float*)(a.ws + WS_SIDE), (bf16*)(a.ws + WS_VF), (bf16*)(a.ws + WS_KF), (bf16*)(a.ws + WS_IKF)};
            pg8::gemm_phase<EpiProj, pg8::StaticOrder, true, true>((LAS unsigned char*)lds, g, S, E);
        }
        xcd_barrier(bar);
        phase_s5(a, l, smem);
        phase_ssd_pre(a, l, smem);
        phase_dsa(a, l, smem);
        xcd_barrier(bar);
        {
            pg8::Gemm g{YG, (const bf16*)(a.ws + WS_WGLU + l * WGLU_L), M_TOK, 512, 512}; pg8::StaticOrder S; S.init(M_TOK, 512, G, obid());
            EpiGlu E{YG, PROJ, a.in[12] + (size_t)l * 512, MIX};
            pg8::gemm_phase<EpiGlu, pg8::StaticOrder, true, true>((LAS unsigned char*)lds, g, S, E);
        }
        phase_ssd1(a);
        xcd_barrier(bar);
        phase_ssd2(a);
        xcd_barrier(bar);
        phase_ssd3(a, l, smem);
        xcd_barrier(bar);
        phase_ssd_norm(a, l);
        xcd_barrier(bar);
        {
            pg8::Gemm g{MIX, (const bf16*)(a.ws + WS_WOUT + l * WOUT_L), M_TOK, D_MODEL, D_MODEL}; pg8::StaticOrder S; S.init(M_TOK, D_MODEL, G, obid());
            EpiOut E{xcur, a.out};
            pg8::gemm_phase<EpiOut, pg8::StaticOrder, true, true>((LAS unsigned char*)lds, g, S, E);
        }
        xcd_barrier(bar);
        if (l + 1 < DEPTH) { phase_rmsnorm_bf16(a.out, a.in[1] + (size_t)(l + 1) * D_MODEL, XB); xcd_barrier(bar); }
    }
    phase_rmsnorm_f32(a.out, a.in[21], a.out);
}

extern "C" void kernel_launch(void* const* d_in, const int* in_sizes, int n_in, void* d_out, int out_size, void* d_ws, size_t ws_size, hipStream_t stream) {
    if (n_in != 22 || out_size != M_TOK * D_MODEL || ws_size < WS_END) {
        fprintf(stderr, "kernel_launch: unexpected problem: n_in %d out %d ws %zu\n", n_in, out_size, ws_size);
        return;
    }
    static int grid_blocks = 0;
    if (!grid_blocks) {
        int dev = 0, cus = 0, per_cu = 0;
        (void)hipGetDevice(&dev);
        (void)hipDeviceGetAttribute(&cus, hipDeviceAttributeMultiprocessorCount, dev);
        (void)hipFuncSetAttribute((const void*)mk_fwd, hipFuncAttributeMaxDynamicSharedMemorySize, LDS_BYTES);
        (void)hipOccupancyMaxActiveBlocksPerMultiprocessor(&per_cu, (const void*)mk_fwd, 512, LDS_BYTES);
        if (per_cu < 1) fprintf(stderr, "kernel_launch: occupancy query says %d blocks/CU\n", per_cu);
        grid_blocks = cus;
    }
    Args a{};
    for (int i = 0; i < 22; ++i) a.in[i] = (const float*)d_in[i];
    a.out = (float*)d_out; a.ws = (unsigned char*)d_ws;
    (void)hipMemsetAsync((char*)d_ws + WS_CTL, 0, 65536, stream);
    void* args[] = {&a};
    hipError_t e = hipLaunchCooperativeKernel((void*)mk_fwd, dim3(grid_blocks), dim3(512), args, LDS_BYTES, stream);
    if (e != hipSuccess) fprintf(stderr, "cooperative launch failed: %s (grid %d)\n", hipGetErrorString(e), grid_blocks);
}
```

```cpp
#include <hip/hip_runtime.h>
#include <cstdint>
#include <cstdio>
#include <hip/hip_cooperative_groups.h>
namespace cg = cooperative_groups;

__device__ __forceinline__ int otid() { int t = threadIdx.x; asm volatile("" : "+v"(t)); return t; }
__device__ __forceinline__ int obid() { int b = blockIdx.x; asm volatile("" : "+s"(b)); return b; }
namespace pg8 {
#define PG8_LAS __attribute__((address_space(3)))
typedef unsigned short bf16_t;
typedef short bf16x8 __attribute__((ext_vector_type(8)));
typedef float f32x4 __attribute__((ext_vector_type(4)));
typedef unsigned u32x4 __attribute__((ext_vector_type(4)));
constexpr int BM = 256, BK = 64, HALF = 128, HTB = HALF * BK * 2  , STAGE_BYTES = 8 * HTB, NXCD = 8, WGM = 8;

__host__ __device__ __forceinline__ int lds_byte(int r, int c) { const int st = (r >> 4) * 2 + (c >> 5), rr = r & 15, cc = c & 31, ob = rr * 64 + cc * 2; return st * 1024 + (ob ^ (((ob >> 9) & 1) << 5)); }
__host__ __device__ __forceinline__ void stage_rc(int b, int& R, int& C) { const int st = b / 1024, sb = b % 1024, swz = sb ^ (((sb >> 9) & 1) << 5); R = (st >> 1) * 16 + swz / 64; C = (st & 1) * 32 + (swz % 64) / 2; }
__host__ __device__ __forceinline__ int perm32(int rho) { const int n = rho >> 4, i = rho & 15; return 8 * (i >> 2) + 4 * n + (i & 3); }

struct Unit { int pm, pn; };
struct Gemm { const bf16_t* A; const bf16_t* Bt; int M, N, K; };

struct StaticOrder {
    int nM, nN, nwg, G, c;
    __host__ __device__ void init(int M, int N, int G_, int c_) { nM = M / BM; nN = N / BM; nwg = nM * nN; G = G_; c = c_; }
    __host__ __device__ bool next(int i, Unit& u) const {
        const long L = (long)i * G + c; if (L >= nwg) return false;
        int wgid = (int)L; { const int q = nwg / NXCD, r = nwg % NXCD, xcd = wgid % NXCD, off = wgid / NXCD; wgid = (xcd < r ? xcd * (q + 1) : r * (q + 1) + (xcd - r) * q) + off; }
        const int nig = WGM * nN, gid = wgid / nig, fm = gid * WGM, gsz = (nM - fm) < WGM ? (nM - fm) : WGM;
        u.pm = fm + ((wgid % nig) % gsz); u.pn = (wgid % nig) / gsz; return true;
    }
    __device__ __forceinline__ void a_ready(const Unit&) const {}
    __device__ __forceinline__ void done(const Unit&) const {}
};


__device__ __forceinline__ unsigned cvt_pk_bf16(float lo, float hi) { unsigned r; asm volatile("v_cvt_pk_bf16_f32 %0, %1, %2" : "=v"(r) : "v"(lo), "v"(hi)); return r; }
template <class Epi, class Sched, bool ALIGN_EPI = false, bool SP2 = false>
__device__ __forceinline__ void gemm_phase(PG8_LAS unsigned char* lds, const Gemm g, const Sched& S, const Epi& E) {
    const int tid = otid(), wid = __builtin_amdgcn_readfirstlane(tid >> 6), lane = tid & 63, wr = wid >> 2, wc = wid & 3, fr = lane & 15, fq = lane >> 4;
    const int K = g.K, nt = K / BK;
    unsigned voffA[2], voffB[2];
#pragma unroll
    for (int i = 0; i < 2; ++i) { int R, C; stage_rc(tid * 16 + i * 8192, R, C); const int Rb = Epi::PERM ? ((R & ~31) + perm32(R & 31)) : R;
        voffA[i] = (unsigned)(R * K + C) * 2u; voffB[i] = (unsigned)(Rb * K + C) * 2u; }
    const size_t kstep = (size_t)(BK * 2);
    const size_t hstep = (size_t)HALF * K * 2;
    const size_t tstep = 2 * hstep;
    const unsigned ldsw = (unsigned)wid * 1024u;
    const int aoff = lds_byte(wr * 64 + fr, fq * 8), boff = lds_byte(wc * 32 + fr, fq * 8);
#define PG8_SA(b, h) (((b) * 2 + (h)) * HTB)
#define PG8_SB(b, h) ((4 + (b) * 2 + (h)) * HTB)
#define PG8_STAGE(bufoff, gbase, voff) do { _Pragma("unroll") for (int _i = 0; _i < 2; ++_i) \
        __builtin_amdgcn_global_load_lds((const unsigned*)((const char*)(gbase) + (voff)[_i]), (PG8_LAS unsigned*)(lds + (bufoff) + ldsw + _i * 8192), 16, 0, 0); } while (0)
#define PG8_LDA(dst, b, h) do { _Pragma("unroll") for (int m = 0; m < 4; ++m) _Pragma("unroll") for (int k = 0; k < 2; ++k) dst[m][k] = *(const PG8_LAS bf16x8*)(lds + PG8_SA(b, h) + aoff + m * 2048 + k * 1024); } while (0)
#define PG8_LDB(dst, b, h) do { _Pragma("unroll") for (int n = 0; n < 2; ++n) _Pragma("unroll") for (int k = 0; k < 2; ++k) dst[n][k] = *(const PG8_LAS bf16x8*)(lds + PG8_SB(b, h) + boff + n * 2048 + k * 1024); } while (0)
#define PG8_MMA(ai, bj, At, Bt) do { __builtin_amdgcn_s_setprio(1); _Pragma("unroll") for (int m = 0; m < 4; ++m) _Pragma("unroll") for (int n = 0; n < 2; ++n) _Pragma("unroll") for (int k = 0; k < 2; ++k) \
        acc[ai][bj][m][n] = __builtin_amdgcn_mfma_f32_16x16x32_bf16(Bt[n][k], At[m][k], acc[ai][bj][m][n], 0, 0, 0); __builtin_amdgcn_s_setprio(0); } while (0)
#define PG8_WAIT_V(n) asm volatile("s_waitcnt vmcnt(" #n ")" ::: "memory")
#define PG8_WAIT_L(n) asm volatile("s_waitcnt lgkmcnt(" #n ")" ::: "memory")
#define PG8_BAR __builtin_amdgcn_s_barrier()
#define PG8_SCHED __builtin_amdgcn_sched_barrier(0)
    Unit cur, nxt; int ui = 0;
    if (!S.next(0, cur)) return;
    f32x4 acc[2][2][4][2];
#pragma unroll
    for (int a = 0; a < 2; ++a)
#pragma unroll
        for (int b = 0; b < 2; ++b)
#pragma unroll
            for (int m = 0; m < 4; ++m)
#pragma unroll
                for (int n = 0; n < 2; ++n) acc[a][b][m][n] = (f32x4){0.f, 0.f, 0.f, 0.f};
    bf16x8 At[4][2], B0[2][2], B1[2][2];
    const char* cA = (const char*)g.A + (size_t)cur.pm * tstep; const char* cB = (const char*)g.Bt + (size_t)cur.pn * tstep;
    S.a_ready(cur);
    if constexpr (SP2) {
        PG8_STAGE(PG8_SB(0, 0), cB, voffB); PG8_STAGE(PG8_SB(0, 1), cB + hstep, voffB); PG8_STAGE(PG8_SA(0, 0), cA, voffA); PG8_STAGE(PG8_SA(0, 1), cA + hstep, voffA);
        if (wr == 1) PG8_BAR;
        PG8_WAIT_V(2); PG8_BAR;
        PG8_STAGE(PG8_SB(1, 0), cB + kstep, voffB); PG8_STAGE(PG8_SA(1, 0), cA + kstep, voffA); PG8_STAGE(PG8_SB(1, 1), cB + hstep + kstep, voffB);
        PG8_WAIT_V(6); PG8_BAR;
    } else {
        PG8_STAGE(PG8_SB(0, 0), cB, voffB); PG8_STAGE(PG8_SA(0, 0), cA, voffA); PG8_STAGE(PG8_SB(0, 1), cB + hstep, voffB); PG8_STAGE(PG8_SA(0, 1), cA + hstep, voffA);
        if (wr == 1) PG8_BAR;
        PG8_WAIT_V(4); PG8_BAR;
        PG8_STAGE(PG8_SB(1, 0), cB + kstep, voffB); PG8_STAGE(PG8_SA(1, 0), cA + kstep, voffA); PG8_STAGE(PG8_SB(1, 1), cB + hstep + kstep, voffB);
        PG8_WAIT_V(6); PG8_BAR;
    }
    for (;;) {
        const bool has_next = S.next(ui + 1, nxt);
        const char* nA = has_next ? (const char*)g.A + (size_t)nxt.pm * tstep : cA; const char* nB = has_next ? (const char*)g.Bt + (size_t)nxt.pn * tstep : cB;
        for (int t = 0; t < nt; t += 2) {
            const bool last = (t == nt - 2);
            const char* a1 = cA + (size_t)(t + 1) * kstep;
            const char* a2 = last ? nA : cA + (size_t)(t + 2) * kstep; const char* b2 = last ? nB : cB + (size_t)(t + 2) * kstep;
            const char* a3 = a2 + kstep; const char* b3 = b2 + kstep;
            if (last && has_next) S.a_ready(nxt);
            if constexpr (SP2) {
            PG8_LDB(B0, 0, 0); PG8_LDB(B1, 0, 1); PG8_SCHED; PG8_LDA(At, 0, 0); PG8_STAGE(PG8_SA(1, 1), a1 + hstep, voffA);
            PG8_WAIT_V(8); PG8_WAIT_L(0); PG8_BAR; PG8_MMA(0, 0, At, B0); PG8_MMA(0, 1, At, B1); PG8_BAR; PG8_SCHED;
            PG8_LDA(At, 0, 1); PG8_STAGE(PG8_SB(0, 0), b2, voffB); PG8_STAGE(PG8_SB(0, 1), b2 + hstep, voffB); PG8_STAGE(PG8_SA(0, 0), a2, voffA);
            PG8_WAIT_V(8); PG8_WAIT_L(0); PG8_BAR; PG8_MMA(1, 0, At, B0); PG8_MMA(1, 1, At, B1); PG8_BAR; PG8_SCHED;
            PG8_LDB(B0, 1, 0); PG8_LDB(B1, 1, 1); PG8_SCHED; PG8_LDA(At, 1, 0); PG8_STAGE(PG8_SA(0, 1), a2 + hstep, voffA);
            PG8_WAIT_V(8); PG8_WAIT_L(0); PG8_BAR; PG8_MMA(0, 0, At, B0); PG8_MMA(0, 1, At, B1); PG8_BAR; PG8_SCHED;
            PG8_LDA(At, 1, 1); PG8_STAGE(PG8_SB(1, 0), b3, voffB); PG8_STAGE(PG8_SB(1, 1), b3 + hstep, voffB); PG8_STAGE(PG8_SA(1, 0), a3, voffA);
            PG8_WAIT_V(8); PG8_WAIT_L(0); PG8_BAR; PG8_MMA(1, 0, At, B0); PG8_MMA(1, 1, At, B1); PG8_BAR; PG8_SCHED;
            } else {
            PG8_LDB(B0, 0, 0); PG8_SCHED; PG8_LDA(At, 0, 0); PG8_STAGE(PG8_SA(1, 1), a1 + hstep, voffA);
            PG8_WAIT_L(8); PG8_BAR; PG8_WAIT_L(0); PG8_MMA(0, 0, At, B0); PG8_BAR; PG8_SCHED;
            PG8_LDB(B1, 0, 1); PG8_STAGE(PG8_SB(0, 0), b2, voffB);
            PG8_BAR; PG8_WAIT_L(0); PG8_MMA(0, 1, At, B1); PG8_BAR;
            PG8_LDA(At, 0, 1); PG8_STAGE(PG8_SA(0, 0), a2, voffA);
            PG8_BAR; PG8_WAIT_L(0); PG8_MMA(1, 0, At, B0); PG8_BAR; PG8_SCHED;
            PG8_STAGE(PG8_SB(0, 1), b2 + hstep, voffB);
            PG8_WAIT_V(6); PG8_BAR; PG8_MMA(1, 1, At, B1); PG8_BAR;
            PG8_LDB(B0, 1, 0); PG8_SCHED; PG8_LDA(At, 1, 0); PG8_STAGE(PG8_SA(0, 1), a2 + hstep, voffA);
            PG8_WAIT_L(8); PG8_BAR; PG8_WAIT_L(0); PG8_MMA(0, 0, At, B0); PG8_BAR; PG8_SCHED;
            PG8_LDB(B1, 1, 1); PG8_STAGE(PG8_SB(1, 0), b3, voffB);
            PG8_BAR; PG8_WAIT_L(0); PG8_MMA(0, 1, At, B1); PG8_BAR;
            PG8_LDA(At, 1, 1); PG8_STAGE(PG8_SA(1, 0), a3, voffA);
            PG8_BAR; PG8_WAIT_L(0); PG8_MMA(1, 0, At, B0); PG8_BAR; PG8_SCHED;
            PG8_STAGE(PG8_SB(1, 1), b3 + hstep, voffB);
            PG8_WAIT_V(6); PG8_BAR; PG8_MMA(1, 1, At, B1); PG8_BAR;
            }
        }
        if constexpr (ALIGN_EPI) { if (wr == 0) PG8_BAR; }
        if constexpr (!Epi::AFTER_DRAIN) { E(acc, cur, wr, wc, fr, fq); S.done(cur); }
        if (!has_next) break;
#pragma unroll
        for (int a = 0; a < 2; ++a)
#pragma unroll
            for (int b = 0; b < 2; ++b)
#pragma unroll
                for (int m = 0; m < 4; ++m)
#pragma unroll
                    for (int n = 0; n < 2; ++n) acc[a][b][m][n] = (f32x4){0.f, 0.f, 0.f, 0.f};
        cur = nxt; cA = nA; cB = nB; ++ui;
        if constexpr (ALIGN_EPI) { if (wr == 1) PG8_BAR; }
    }
    PG8_WAIT_V(0);
    if constexpr (!ALIGN_EPI) { if (wr == 0) PG8_BAR; }
    PG8_BAR;
    if constexpr (Epi::AFTER_DRAIN) { E.fused(acc, cur, wr, wc, fr, fq, lds, wid, lane); S.done(cur); }
#undef PG8_SA
#undef PG8_SB
#undef PG8_STAGE
#undef PG8_LDA
#undef PG8_LDB
#undef PG8_MMA
#undef PG8_WAIT_V
#undef PG8_WAIT_L
#undef PG8_BAR
#undef PG8_SCHED
}
}

constexpr int D_MODEL = 2048, BATCH = 4, SEQ = 2048, DEPTH = 2;
constexpr int M_TOK = BATCH * SEQ;
constexpr int D_IN = 5848;
constexpr float EPS = 1e-6f;
constexpr int PP = 5888;
constexpr int P_S5U = 0, P_S5Z = 512, P_SSDZ = 1024, P_XBC = 2048, P_AQ = 4096, P_IQ = 4608, P_AZ = 5120, P_AK = 5632, P_AV = 5696, P_IK = 5760, P_DT = 5824, P_IW = 5840;
constexpr int MX_S5 = 0, MX_SSD = 512, MX_ATT = 1536;

typedef unsigned short bf16;
typedef unsigned u32x4 __attribute__((ext_vector_type(4)));
typedef unsigned u32x2 __attribute__((ext_vector_type(2)));
typedef float f32x4 __attribute__((ext_vector_type(4)));
#define LAS __attribute__((address_space(3)))

constexpr size_t MiB = 1u << 20;
constexpr size_t WS_CTL = 0;
constexpr size_t WS_WIN = 2 * MiB;
constexpr size_t WIN_L = (size_t)PP * 2048 * 2;
constexpr size_t WS_WOUT = 48 * MiB;
constexpr size_t WOUT_L = (size_t)2048 * 2048 * 2;
constexpr size_t WS_WGLU = 64 * MiB;
constexpr size_t WGLU_L = (size_t)512 * 512 * 2;
constexpr size_t WS_S5P = 65 * MiB;
constexpr size_t WS_SIDE = 66 * MiB;
constexpr size_t WS_XB = 68 * MiB;
constexpr size_t WS_PROJ = 100 * MiB;
constexpr size_t WS_MIX = 192 * MiB;
constexpr size_t WS_YG = 224 * MiB;
constexpr size_t WS_DTS = 67 * MiB;
constexpr size_t WS_CS = WS_DTS + 512 * 1024;
constexpr size_t WS_XC = 232 * MiB;
constexpr size_t WS_XT1 = 264 * MiB;
constexpr size_t WS_XT2 = 280 * MiB;
constexpr size_t WS_BTR = 296 * MiB;
constexpr size_t WS_CST = 304 * MiB;
constexpr size_t WS_SSQ = 336 * MiB;
constexpr size_t WS_BTAB = 336 * MiB + 512 * 1024;
constexpr size_t WS_SSQX = 336 * MiB + 768 * 1024;
constexpr size_t WS_VF = 337 * MiB;
constexpr size_t WS_KF = 338 * MiB;
constexpr size_t WS_IKF = 339 * MiB;
constexpr size_t WS_END = 340 * MiB;
static_assert(WS_WIN + 2 * WIN_L <= WS_WOUT && WS_WOUT + 2 * WOUT_L <= WS_WGLU, "ws map");

struct Args {
    const float* in[22];
    float* out;
    unsigned char* ws;
};

__device__ __forceinline__ float bf2f(unsigned v) { return __uint_as_float(v << 16); }
__device__ __forceinline__ unsigned f2bf(float f) { unsigned u = __float_as_uint(f); return (u + 0x7fffu + ((u >> 16) & 1u)) >> 16; }
__device__ __forceinline__ unsigned pk2(float lo, float hi) { unsigned r; asm("v_cvt_pk_bf16_f32 %0, %1, %2" : "=v"(r) : "v"(lo), "v"(hi)); return r; }
__device__ __forceinline__ float4 ldbf4(const bf16* p) { const u32x2 u = *(const u32x2*)p; float4 r; r.x = __uint_as_float(u.x << 16); r.y = __uint_as_float(u.x & 0xffff0000u); r.z = __uint_as_float(u.y << 16); r.w = __uint_as_float(u.y & 0xffff0000u); return r; }
__device__ __forceinline__ void unpack8(const u32x4 u, float* f) {
    f[0] = __uint_as_float(u.x << 16); f[1] = __uint_as_float(u.x & 0xffff0000u); f[2] = __uint_as_float(u.y << 16); f[3] = __uint_as_float(u.y & 0xffff0000u);
    f[4] = __uint_as_float(u.z << 16); f[5] = __uint_as_float(u.z & 0xffff0000u); f[6] = __uint_as_float(u.w << 16); f[7] = __uint_as_float(u.w & 0xffff0000u);
}

__device__ __forceinline__ float wave_sum(float v) {
#pragma unroll
    for (int o = 1; o < 64; o <<= 1) v += __shfl_xor(v, o);
    return v;
}
__device__ __forceinline__ float wave_max(float v) {
#pragma unroll
    for (int o = 1; o < 64; o <<= 1) v = fmaxf(v, __shfl_xor(v, o));
    return v;
}
__device__ __forceinline__ float rows_sum4(float x) {
    auto r = __builtin_amdgcn_permlane32_swap(__float_as_uint(x), __float_as_uint(x), false, false); x = __uint_as_float(r[0]) + __uint_as_float(r[1]);
    auto q = __builtin_amdgcn_permlane16_swap(__float_as_uint(x), __float_as_uint(x), false, false); return __uint_as_float(q[0]) + __uint_as_float(q[1]);
}
__device__ __forceinline__ float sigmoidf_(float x) { return __builtin_amdgcn_rcpf(1.0f + __builtin_amdgcn_exp2f(-1.4426950408889634f * x)); }
__device__ __forceinline__ float siluf(float x) { return x * sigmoidf_(x); }
__device__ __forceinline__ float gelu_tanh(float x) { return x * sigmoidf_(1.5957691216057308f * (x + 0.044715f * x * x * x)); }
__device__ __forceinline__ float softplusf_(float x) { return fmaxf(x, 0.f) + log1pf(expf(-fabsf(x))); }

struct EpiProj {
    static constexpr bool PERM = true, AFTER_DRAIN = false;
    bf16* P; float* side; bf16* VF; bf16* KF; bf16* IKF; const float* ssqx;
    __device__ __forceinline__ void operator()(const pg8::f32x4 (&acc)[2][2][4][2], const pg8::Unit& u, int wr, int wc, int fr, int fq) const {
        const int row0 = u.pm * 256 + wr * 64 + fr, col0 = u.pn * 256 + wc * 32 + 8 * fq;
        const bool last = (u.pn == 22);
        const bool sidew = last && (wc == 2) && (fq < 3);
#pragma unroll
        for (int ai = 0; ai < 2; ++ai)
#pragma unroll
            for (int m = 0; m < 4; ++m) {
                const int row = row0 + ai * 128 + m * 16;
                bf16* rowp = P + (size_t)row * PP + col0;
                const int bb = row >> 11, t = row & 2047;
                const pg8::f32x4 q0 = *(const pg8::f32x4*)(ssqx + (size_t)row * 8), q1 = *(const pg8::f32x4*)(ssqx + (size_t)row * 8 + 4);
                const float rs = 1.0f / sqrtf(((q0[0] + q0[1]) + (q0[2] + q0[3]) + (q1[0] + q1[1]) + (q1[2] + q1[3])) * (1.0f / D_MODEL) + EPS);
#pragma unroll
                for (int bj = 0; bj < 2; ++bj) {
                    const pg8::f32x4 v0 = acc[ai][bj][m][0] * rs, v1 = acc[ai][bj][m][1] * rs;
                    u32x4 w; w.x = pg8::cvt_pk_bf16(v0[0], v0[1]); w.y = pg8::cvt_pk_bf16(v0[2], v0[3]); w.z = pg8::cvt_pk_bf16(v1[0], v1[1]); w.w = pg8::cvt_pk_bf16(v1[2], v1[3]);
                    *(u32x4*)(rowp + bj * 128) = w;
                    if (last) {
                        if (bj == 1 && sidew) { float* sp = side + (size_t)row * 32 + 8 * fq; *(pg8::f32x4*)sp = v0; *(pg8::f32x4*)(sp + 4) = v1; }
                        if (wc < 2) {
                            if (bj == 0) *(u32x4*)(KF + ((((size_t)(bb * 64 + (t >> 5)) * 2 + ((t >> 4) & 1)) * 2 + wc) * 64 + fq * 16 + (t & 15)) * 8) = w;
                            else *(u32x4*)(IKF + (((size_t)(bb * 128 + (t >> 4)) * 2 + wc) * 64 + fq * 16 + (t & 15)) * 8) = w;
                        } else if (bj == 0) {
                            const int kk32 = t & 31;
                            bf16* vp = VF + ((((size_t)(bb * 64 + (t >> 5)) * 4 + (wc - 2) * 2 + (fq >> 1)) * 64 + ((kk32 & 15) >> 2) * 16 + 8 * (fq & 1)) * 8) + (kk32 >> 4) * 4 + (kk32 & 3);
#pragma unroll
                            for (int e = 0; e < 4; ++e) { vp[e * 8] = (bf16)f2bf(v0[e]); vp[(4 + e) * 8] = (bf16)f2bf(v1[e]); }
                        }
                    }
                }
            }
    }
};
struct EpiOutNorm {
    static constexpr bool PERM = false, AFTER_DRAIN = true;
    const float* base; float* out; bf16* xb; float* ssqx;
    __device__ __forceinline__ void fused(pg8::f32x4 (&acc)[2][2][4][2], const pg8::Unit& u, int wr, int wc, int fr, int fq, PG8_LAS unsigned char* lds, int wid, int lane) const {
        PG8_LAS float* Pl = (PG8_LAS float*)lds;
        const int col0 = u.pn * 256 + wc * 32 + 4 * fq;
#pragma unroll
        for (int ai = 0; ai < 2; ++ai)
#pragma unroll
            for (int m = 0; m < 4; ++m) {
                const int rl = ai * 128 + wr * 64 + m * 16 + fr; const size_t off = (size_t)(u.pm * 256 + rl) * D_MODEL + col0;
                float ss = 0.f;
#pragma unroll
                for (int bj = 0; bj < 2; ++bj)
#pragma unroll
                    for (int n = 0; n < 2; ++n) {
                        const pg8::f32x4 bs = *(const pg8::f32x4*)(base + off + bj * 128 + n * 16);
                        const pg8::f32x4 v = bs + acc[ai][bj][m][n];
                        *(pg8::f32x4*)(out + off + bj * 128 + n * 16) = v;
                        ss += (v[0] * v[0] + v[1] * v[1]) + (v[2] * v[2] + v[3] * v[3]);
                        u32x2 w; w.x = pg8::cvt_pk_bf16(v[0], v[1]); w.y = pg8::cvt_pk_bf16(v[2], v[3]);
                        *(u32x2*)(xb + off + bj * 128 + n * 16) = w;
                    }
                ss = rows_sum4(ss);
                if (fq == 0) Pl[rl * 4 + wc] = ss;
            }
        asm volatile("s_waitcnt lgkmcnt(0)" ::: "memory"); __builtin_amdgcn_s_barrier(); asm volatile("" ::: "memory");
        const int tid = wid * 64 + lane;
        if (tid < 256) { const float p0 = Pl[tid * 4], p1 = Pl[tid * 4 + 1], p2 = Pl[tid * 4 + 2], p3 = Pl[tid * 4 + 3]; ssqx[(size_t)(u.pm * 256 + tid) * 8 + u.pn] = (p0 + p1) + (p2 + p3); }
    }
};
struct EpiGlu {
    static constexpr bool PERM = true, AFTER_DRAIN = false;
    const bf16* yg; const bf16* proj; const float* gb; bf16* mix;
    __device__ __forceinline__ void operator()(const pg8::f32x4 (&acc)[2][2][4][2], const pg8::Unit& u, int wr, int wc, int fr, int fq) const {
        const int row0 = u.pm * 256 + wr * 64 + fr, col0 = u.pn * 256 + wc * 32 + 8 * fq;
#pragma unroll
        for (int ai = 0; ai < 2; ++ai)
#pragma unroll
            for (int m = 0; m < 4; ++m) {
                const int row = row0 + ai * 128 + m * 16;
#pragma unroll
                for (int bj = 0; bj < 2; ++bj) {
                    const int c = col0 + bj * 128;
                    float y[8], z[8], o[8];
                    unpack8(*(const u32x4*)(yg + (size_t)row * 512 + c), y);
                    unpack8(*(const u32x4*)(proj + (size_t)row * PP + P_S5Z + c), z);
                    const pg8::f32x4 b0 = *(const pg8::f32x4*)(gb + c), b1 = *(const pg8::f32x4*)(gb + c + 4);
                    const pg8::f32x4 v0 = acc[ai][bj][m][0] + b0, v1 = acc[ai][bj][m][1] + b1;
#pragma unroll
                    for (int j = 0; j < 4; ++j) { o[j] = y[j] * sigmoidf_(v0[j]) * siluf(z[j]); o[4 + j] = y[4 + j] * sigmoidf_(v1[j]) * siluf(z[4 + j]); }
                    u32x4 w; w.x = pk2(o[0], o[1]); w.y = pk2(o[2], o[3]); w.z = pk2(o[4], o[5]); w.w = pk2(o[6], o[7]);
                    *(u32x4*)(mix + (size_t)row * D_MODEL + MX_S5 + c) = w;
                }
            }
    }
};

__device__ __forceinline__ int win_src_col(int n) {
    if (n < 4096) return n;
    if (n < 4608) return n - 4096 + 4112;
    if (n < 5120) return n - 4608 + 4752;
    if (n < 5632) return n - 5120 + 5336;
    if (n < 5696) return n - 5632 + 4624;
    if (n < 5760) return n - 5696 + 4688;
    if (n < 5824) return n - 5760 + 5264;
    if (n < 5840) return n - 5824 + 4096;
    if (n < 5848) return n - 5840 + 5328;
    return -1;
}
template <int MODE>
__device__ __forceinline__ void transpose_item(const float* W, int K, int Nsrc, bf16* WT, float* scr, int kb, int nb, int lane, const float* kscale) {
    const int k0 = 64 * kb, n0 = 32 * nb;
    const int nsrc = (MODE == 1) ? win_src_col(n0 + (lane & 31)) : (n0 + (lane & 31));
    float v[32];
#pragma unroll
    for (int i = 0; i < 32; ++i) { const int kk = 2 * i + (lane >> 5); v[i] = (nsrc >= 0) ? W[(size_t)(k0 + kk) * Nsrc + nsrc] : 0.f; }
    if (MODE == 1) {
#pragma unroll
        for (int i = 0; i < 32; ++i) v[i] *= kscale[k0 + 2 * i + (lane >> 5)];
    }
#pragma unroll
    for (int i = 0; i < 32; ++i) scr[(2 * i + (lane >> 5)) * 33 + (lane & 31)] = v[i];
    asm volatile("s_waitcnt lgkmcnt(0)" ::: "memory");
    const int c = lane & 7;
#pragma unroll
    for (int j = 0; j < 4; ++j) { const int n = (lane >> 3) + 8 * j; const float* s = scr + (8 * c) * 33 + n;
        u32x4 o; o.x = pk2(s[0 * 33], s[1 * 33]); o.y = pk2(s[2 * 33], s[3 * 33]); o.z = pk2(s[4 * 33], s[5 * 33]); o.w = pk2(s[6 * 33], s[7 * 33]);
        *(u32x4*)(WT + (size_t)(n0 + n) * K + k0 + 8 * c) = o; }
    asm volatile("s_waitcnt lgkmcnt(0)" ::: "memory");
}

constexpr size_t S5P_LAM = 0, S5P_BBT = 64 * 1024, S5P_CT = 64 * 1024 + 256 * 1024;
__device__ __forceinline__ void phase_s5_params(const Args& a) {
    float* lam = (float*)(a.ws + WS_S5P + S5P_LAM);
    bf16* BBT = (bf16*)(a.ws + WS_S5P + S5P_BBT);
    bf16* CT = (bf16*)(a.ws + WS_S5P + S5P_CT);
    const int gt = obid() * 512 + otid();
    if (gt >= 2 * 32 * 64) return;
    const int l = gt / 2048, g = (gt / 64) % 32, p = gt % 64;
    const float A_re = a.in[3][gt], A_im = a.in[4][gt];
    const float dt = expf(a.in[5][l * 32 + g]);
    const float lre = fminf(A_re, -1e-4f), lim = A_im;
    const float mag = expf(lre * dt);
    const float lbr = mag * cosf(lim * dt), lbi = mag * sinf(lim * dt);
    const float nr = lbr - 1.0f, ni = lbi;
    const float den = lre * lre + lim * lim;
    const float fr = (nr * lre + ni * lim) / den, fi = (ni * lre - nr * lim) / den;
    lam[gt * 2] = lbr; lam[gt * 2 + 1] = lbi;
    for (int c = 0; c < 16; ++c) {
        const float Bre = a.in[6][gt * 16 + c], Bim = a.in[7][gt * 16 + c];
        BBT[((size_t)(l * 32 + g) * 128 + p) * 16 + c] = (bf16)f2bf(fr * Bre - fi * Bim);
        BBT[((size_t)(l * 32 + g) * 128 + 64 + p) * 16 + c] = (bf16)f2bf(fr * Bim + fi * Bre);
        CT[((size_t)(l * 32 + g) * 16 + c) * 128 + p] = (bf16)f2bf(a.in[8][((size_t)(l * 32 + g) * 16 + c) * 64 + p]);
        CT[((size_t)(l * 32 + g) * 16 + c) * 128 + 64 + p] = (bf16)f2bf(-a.in[9][((size_t)(l * 32 + g) * 16 + c) * 64 + p]);
    }
}

__device__ __forceinline__ void phase_cast_ssq(const float* X, bf16* XB, float* ssqx) {
    const int wave = otid() >> 6, lane = otid() & 63;
    for (int row = obid() * 8 + wave; row < M_TOK; row += gridDim.x * 8) {
        const float4* xr = (const float4*)(X + (size_t)row * D_MODEL);
        float4 v[8]; float s = 0.f;
#pragma unroll
        for (int j = 0; j < 8; ++j) { v[j] = xr[lane + 64 * j]; s += v[j].x * v[j].x + v[j].y * v[j].y + v[j].z * v[j].z + v[j].w * v[j].w; }
        s = wave_sum(s);
        u32x2* hr = (u32x2*)(XB + (size_t)row * D_MODEL);
#pragma unroll
        for (int j = 0; j < 8; ++j) { u32x2 o; o.x = pk2(v[j].x, v[j].y); o.y = pk2(v[j].z, v[j].w); hr[lane + 64 * j] = o; }
        if (lane < 8) ssqx[(size_t)row * 8 + lane] = (lane == 0) ? s : 0.f;
    }
}
__device__ __forceinline__ void phase_final_norm(float* X, const float* w, const float* ssqx) {
    const int wave = otid() >> 6, lane = otid() & 63;
    for (int row = obid() * 8 + wave; row < M_TOK; row += gridDim.x * 8) {
        const float4 q0 = *(const float4*)(ssqx + (size_t)row * 8), q1 = *(const float4*)(ssqx + (size_t)row * 8 + 4);
        const float rs = 1.0f / sqrtf(((q0.x + q0.y) + (q0.z + q0.w) + (q1.x + q1.y) + (q1.z + q1.w)) * (1.0f / D_MODEL) + EPS);
        float4* xr = (float4*)(X + (size_t)row * D_MODEL);
#pragma unroll
        for (int j = 0; j < 8; ++j) { float4 v = xr[lane + 64 * j]; const float4 ww = ((const float4*)w)[lane + 64 * j];
            v.x *= rs * ww.x; v.y *= rs * ww.y; v.z *= rs * ww.z; v.w *= rs * ww.w; xr[lane + 64 * j] = v; }
    }
}

__device__ __forceinline__ void phase_prologue(const Args& a, float* smem) {
    const int wave = otid() >> 6, lane = otid() & 63;
    float* scr = smem + wave * 4096;
    const int gw = obid() * 8 + wave, NGW = gridDim.x * 8;
    constexpr int I_IN = 32 * (PP / 32), I_OUT = 32 * 64, I_GLU = 8 * 16;
    constexpr int NIT = 2 * (I_IN + I_OUT + I_GLU);
    for (int it = gw; it < NIT; it += NGW) {
        int r = it; const int l = r / (I_IN + I_OUT + I_GLU); r -= l * (I_IN + I_OUT + I_GLU);
        if (r < I_IN) { transpose_item<1>(a.in[2] + (size_t)l * D_MODEL * D_IN, 2048, D_IN, (bf16*)(a.ws + WS_WIN + l * WIN_L), scr, r / (PP / 32), r % (PP / 32), lane, a.in[1] + (size_t)l * D_MODEL); continue; }
        r -= I_IN;
        if (r < I_OUT) { transpose_item<0>(a.in[20] + (size_t)l * D_MODEL * D_MODEL, 2048, 2048, (bf16*)(a.ws + WS_WOUT + l * WOUT_L), scr, r / 64, r % 64, lane, nullptr); continue; }
        r -= I_OUT;
        transpose_item<0>(a.in[11] + (size_t)l * 512 * 512, 512, 512, (bf16*)(a.ws + WS_WGLU + l * WGLU_L), scr, r / 16, r % 16, lane, nullptr);
    }
    phase_s5_params(a);
    phase_cast_ssq(a.in[0], (bf16*)(a.ws + WS_XB), (float*)(a.ws + WS_SSQX));
}

typedef short bf16x8 __attribute__((ext_vector_type(8)));
typedef float f32x16 __attribute__((ext_vector_type(16)));
#define MFMA32(a, b, c) __builtin_amdgcn_mfma_f32_32x32x16_bf16((a), (b), (c), 0, 0, 0)
#define MFMA16(a, b, c) __builtin_amdgcn_mfma_f32_16x16x32_bf16((a), (b), (c), 0, 0, 0)
__device__ __forceinline__ int crow(int r, int hh) { return (r & 3) + 8 * (r >> 2) + 4 * hh; }
__device__ __forceinline__ bf16x8 ld16(const bf16* p) { return *(const bf16x8*)p; }
__device__ __forceinline__ bf16x8 ld8x2(const bf16* p0, const bf16* p1) { const u32x2 x = *(const u32x2*)p0, y = *(const u32x2*)p1; const u32x4 v = {x.x, x.y, y.x, y.y}; return __builtin_bit_cast(bf16x8, v); }
__device__ __forceinline__ f32x16 zero16() { f32x16 z;
#pragma unroll
    for (int i = 0; i < 16; ++i) z[i] = 0.f; return z; }

template <bool OUT>
__device__ __forceinline__ void s5_tile(const bf16* proj, bf16* yg, float* T, size_t row0, int g, int lane, const bf16x8 uf, const bf16x8 (&bb)[4], const bf16x8 (&ct)[4], float ar, float ai, float dd, float& xr, float& xi) {
    const int r = lane & 31, hh = lane >> 5, cc = lane & 15, q4 = lane >> 4;
    float ulv[2][4];
    if (OUT) {
#pragma unroll
        for (int mt = 0; mt < 2; ++mt)
#pragma unroll
            for (int rg = 0; rg < 4; ++rg) ulv[mt][rg] = bf2f(proj[(row0 + mt * 16 + q4 * 4 + rg) * PP + P_S5U + g * 16 + cc]);
    }
#pragma unroll
    for (int nb = 0; nb < 4; ++nb) {
        const f32x16 acc = MFMA32(uf, bb[nb], zero16());
#pragma unroll
        for (int rg = 0; rg < 16; ++rg) T[crow(rg, hh) * 132 + nb * 32 + r] = acc[rg];
    }
    asm volatile("s_waitcnt lgkmcnt(0)" ::: "memory");
#pragma unroll 8
    for (int t = 0; t < 32; ++t) {
        const float bur = T[t * 132 + lane], bui = T[t * 132 + 64 + lane];
        const float nxr = fmaf(ar, xr, fmaf(-ai, xi, bur));
        const float nxi = fmaf(ar, xi, fmaf(ai, xr, bui));
        xr = nxr; xi = nxi;
        if (OUT) { T[t * 132 + lane] = xr; T[t * 132 + 64 + lane] = xi; }
    }
    if (OUT) {
        asm volatile("s_waitcnt lgkmcnt(0)" ::: "memory");
#pragma unroll
        for (int mt = 0; mt < 2; ++mt) {
            f32x4 y = {0.f, 0.f, 0.f, 0.f};
#pragma unroll
            for (int kk = 0; kk < 4; ++kk) {
                const float* tp = T + (mt * 16 + cc) * 132 + kk * 32 + 8 * q4;
                const float4 f0 = *(const float4*)tp, f1 = *(const float4*)(tp + 4);
                u32x4 av; av.x = pk2(f0.x, f0.y); av.y = pk2(f0.z, f0.w); av.z = pk2(f1.x, f1.y); av.w = pk2(f1.z, f1.w);
                y = MFMA16(__builtin_bit_cast(bf16x8, av), ct[kk], y);
            }
#pragma unroll
            for (int rg = 0; rg < 4; ++rg) {
                const size_t row = row0 + mt * 16 + q4 * 4 + rg;
                yg[row * 512 + g * 16 + cc] = (bf16)f2bf(gelu_tanh(y[rg] + dd * ulv[mt][rg]));
            }
        }
    }
    asm volatile("s_waitcnt lgkmcnt(0)" ::: "memory");
}
#define S5_UF(tile_) ld16(proj + (rowb + (tile_) * 32 + r) * PP + P_S5U + g * 16 + 8 * hh)
#define S5_PASS(OUT_) do { bf16x8 ufA = S5_UF(0), ufB; \
        _Pragma("unroll 1") for (int tile = 0; tile < 8; tile += 2) { \
            ufB = S5_UF(tile + 1); asm volatile("" ::: "memory"); \
            s5_tile<OUT_>(proj, yg, T, rowb + tile * 32, g, lane, ufA, bb, ct, ar, ai, dd, xr, xi); \
            ufA = S5_UF((tile + 2 < 8) ? tile + 2 : tile); asm volatile("" ::: "memory"); \
            s5_tile<OUT_>(proj, yg, T, rowb + (tile + 1) * 32, g, lane, ufB, bb, ct, ar, ai, dd, xr, xi); } } while (0)

__device__ __forceinline__ void phase_s5(const Args& a, int l, float* smem) {
    const bf16* proj = (const bf16*)(a.ws + WS_PROJ);
    bf16* yg = (bf16*)(a.ws + WS_YG);
    const float* lam = (const float*)(a.ws + WS_S5P + S5P_LAM) + (size_t)l * 32 * 64 * 2;
    const bf16* BBT = (const bf16*)(a.ws + WS_S5P + S5P_BBT) + (size_t)l * 32 * 128 * 16;
    const bf16* CT = (const bf16*)(a.ws + WS_S5P + S5P_CT) + (size_t)l * 32 * 16 * 128;
    const float* Dp = a.in[10] + (size_t)l * 512;
    const int tid = otid(), wave = tid >> 6, lane = tid & 63, r = lane & 31, hh = lane >> 5, cc = lane & 15, q4 = lane >> 4;
    float* T = smem + wave * 4224;
    float* segend = smem + 8 * 4224;
    for (int unit = obid(); unit < BATCH * 32; unit += gridDim.x) {
        const int b = unit >> 5, g = unit & 31;
        const float ar = lam[(g * 64 + lane) * 2], ai = lam[(g * 64 + lane) * 2 + 1];
        bf16x8 bb[4], ct[4];
#pragma unroll
        for (int nb = 0; nb < 4; ++nb) bb[nb] = ld16(BBT + ((size_t)(g * 128 + nb * 32 + r)) * 16 + 8 * hh);
#pragma unroll
        for (int kk = 0; kk < 4; ++kk) ct[kk] = ld16(CT + ((size_t)(g * 16 + cc)) * 128 + kk * 32 + 8 * q4);
        const float dd = Dp[g * 16 + cc];
        __syncthreads();
        float xr = 0.f, xi = 0.f;
        const size_t rowb = (size_t)b * SEQ + wave * 256;
        S5_PASS(false);
        segend[wave * 128 + lane] = xr; segend[wave * 128 + 64 + lane] = xi;
        __syncthreads();
        float pr = ar, pi = ai;
#pragma unroll
        for (int i = 0; i < 8; ++i) { const float t = pr * pr - pi * pi; pi = 2.f * pr * pi; pr = t; }
        float cr = 0.f, ci = 0.f;
        for (int w2 = 0; w2 < wave; ++w2) { const float sr = segend[w2 * 128 + lane], si = segend[w2 * 128 + 64 + lane]; const float t = pr * cr - pi * ci + sr; ci = pr * ci + pi * cr + si; cr = t; }
        xr = cr; xi = ci;
        S5_PASS(true);
    }
}


__device__ __forceinline__ void phase_ssd_pre(const Args& a, int l, float* smem) {
    const bf16* proj = (const bf16*)(a.ws + WS_PROJ);
    const float* side = (const float*)(a.ws + WS_SIDE);
    float* DTS = (float*)(a.ws + WS_DTS); float* CS = (float*)(a.ws + WS_CS);
    bf16* XC = (bf16*)(a.ws + WS_XC); bf16* XT1 = (bf16*)(a.ws + WS_XT1); bf16* XT2 = (bf16*)(a.ws + WS_XT2); bf16* BTR = (bf16*)(a.ws + WS_BTR);
    const float* cw = a.in[13] + (size_t)l * 4 * 2048;
    const float* cb = a.in[14] + (size_t)l * 2048;
    float* dtl = smem; float* csl = smem + 1024;
    const int tid = otid(), wave = tid >> 6, lane = tid & 63;
    for (int u = obid(); u < 512; u += gridDim.x) {
        const int b = u >> 7, c = (u >> 2) & 31, q = u & 3;
        const size_t row0 = (size_t)b * SEQ + c * 64;
        __syncthreads();
#pragma unroll
        for (int k = 0; k < 2; ++k) {
            const int h = wave * 2 + k;
            const float dtv = softplusf_(side[(row0 + lane) * 32 + h] + a.in[15][l * 16 + h]);
            float v = dtv * (-__expf(a.in[16][l * 16 + h]));
#pragma unroll
            for (int o = 1; o < 64; o <<= 1) { const float t = __shfl_up(v, o); if (lane >= o) v += t; }
            dtl[lane * 16 + h] = dtv; csl[lane * 16 + h] = v;
            if (q == 0) { DTS[(row0 + lane) * 16 + h] = dtv; CS[(row0 + lane) * 16 + h] = v; }
        }
        __syncthreads();
        const int cp = tid & 255, th = tid >> 8, ch = q * 512 + 2 * cp;
        float w0[4], w1[4];
#pragma unroll
        for (int k = 0; k < 4; ++k) { w0[k] = cw[k * 2048 + ch]; w1[k] = cw[k * 2048 + ch + 1]; }
        const float b0 = cb[ch], b1 = cb[ch + 1];
        const bf16* pcol = proj + P_XBC + ch;
        unsigned raw[35];
#pragma unroll
        for (int i = 0; i < 35; ++i) {
            const int t = th * 32 - 3 + i;
            raw[i] = 0u; if (c * 64 + t >= 0) raw[i] = *(const unsigned*)(pcol + (row0 + t) * PP);
        }
        const int hx = ch >> 6;
#pragma unroll
        for (int grp = 0; grp < 4; ++grp) {
            const int t0 = th * 32 + grp * 8;
            float xa[11], xb[11];
#pragma unroll
            for (int i = 0; i < 11; ++i) { xa[i] = __uint_as_float(raw[grp * 8 + i] << 16); xb[i] = __uint_as_float(raw[grp * 8 + i] & 0xffff0000u); }
            float ya[8], yb[8];
#pragma unroll
            for (int i = 0; i < 8; ++i) {
                float s0 = b0, s1 = b1;
#pragma unroll
                for (int k = 0; k < 4; ++k) { s0 = fmaf(w0[k], xa[i + k], s0); s1 = fmaf(w1[k], xb[i + k], s1); }
                ya[i] = siluf(s0); yb[i] = siluf(s1);
                *(unsigned*)(XC + (row0 + t0 + i) * 2048 + ch) = pk2(ya[i], yb[i]);
            }
            if (q < 2) {
                bf16* d1 = XT1 + ((size_t)b * 1024 + ch) * 2048 + c * 64 + t0;
                bf16* d2 = XT2 + ((size_t)b * 1024 + ch) * 2048 + c * 64 + t0;
                u32x4 o; o.x = pk2(ya[0], ya[1]); o.y = pk2(ya[2], ya[3]); o.z = pk2(ya[4], ya[5]); o.w = pk2(ya[6], ya[7]); *(u32x4*)d1 = o;
                o.x = pk2(yb[0], yb[1]); o.y = pk2(yb[2], yb[3]); o.z = pk2(yb[4], yb[5]); o.w = pk2(yb[6], yb[7]); *(u32x4*)(d1 + 2048) = o;
                float wg[8]; const float cend = csl[63 * 16 + hx];
#pragma unroll
                for (int i = 0; i < 8; ++i) wg[i] = dtl[(t0 + i) * 16 + hx] * __expf(cend - csl[(t0 + i) * 16 + hx]);
                o.x = pk2(ya[0] * wg[0], ya[1] * wg[1]); o.y = pk2(ya[2] * wg[2], ya[3] * wg[3]); o.z = pk2(ya[4] * wg[4], ya[5] * wg[5]); o.w = pk2(ya[6] * wg[6], ya[7] * wg[7]); *(u32x4*)d2 = o;
                o.x = pk2(yb[0] * wg[0], yb[1] * wg[1]); o.y = pk2(yb[2] * wg[2], yb[3] * wg[3]); o.z = pk2(yb[4] * wg[4], yb[5] * wg[5]); o.w = pk2(yb[6] * wg[6], yb[7] * wg[7]); *(u32x4*)(d2 + 2048) = o;
            } else if (q == 2) {
                bf16* d1 = BTR + ((size_t)b * 512 + (ch - 1024)) * 2048 + c * 64 + t0;
                u32x4 o; o.x = pk2(ya[0], ya[1]); o.y = pk2(ya[2], ya[3]); o.z = pk2(ya[4], ya[5]); o.w = pk2(ya[6], ya[7]); *(u32x4*)d1 = o;
                o.x = pk2(yb[0], yb[1]); o.y = pk2(yb[2], yb[3]); o.z = pk2(yb[4], yb[5]); o.w = pk2(yb[6], yb[7]); *(u32x4*)(d1 + 2048) = o;
            }
        }
    }
}

__device__ __forceinline__ void phase_ssd1(const Args& a) {
    const bf16* XT2 = (const bf16*)(a.ws + WS_XT2); const bf16* BTR = (const bf16*)(a.ws + WS_BTR); bf16* CST = (bf16*)(a.ws + WS_CST);
    const int tid = otid(), wave = tid >> 6, lane = tid & 63, r = lane & 31, hh = lane >> 5;
    for (int u = obid() * 8 + wave; u < 2048; u += gridDim.x * 8) {
        const int b = u >> 9, c = (u >> 4) & 31, h = u & 15, g = h >> 2;
        bf16x8 af[2][4];
#pragma unroll
        for (int pb = 0; pb < 2; ++pb)
#pragma unroll
            for (int kk = 0; kk < 4; ++kk) af[pb][kk] = ld16(XT2 + ((size_t)b * 1024 + h * 64 + pb * 32 + r) * 2048 + c * 64 + kk * 16 + 8 * hh);
        bf16* outb = CST + ((size_t)((b * 32 + c) * 16 + h)) * 64 * 128;
#pragma unroll 1
        for (int nb = 0; nb < 4; ++nb) {
            bf16x8 bfr[4];
#pragma unroll
            for (int kk = 0; kk < 4; ++kk) bfr[kk] = ld16(BTR + ((size_t)b * 512 + g * 128 + nb * 32 + r) * 2048 + c * 64 + kk * 16 + 8 * hh);
#pragma unroll
            for (int pb = 0; pb < 2; ++pb) {
                f32x16 acc = zero16();
#pragma unroll
                for (int kk = 0; kk < 4; ++kk) acc = MFMA32(af[pb][kk], bfr[kk], acc);
#pragma unroll
                for (int rg = 0; rg < 16; ++rg) outb[(pb * 32 + crow(rg, hh)) * 128 + nb * 32 + r] = (bf16)f2bf(acc[rg]);
            }
        }
    }
}

__device__ __forceinline__ void phase_ssd2(const Args& a) {
    const float* CS = (const float*)(a.ws + WS_CS); bf16* CST = (bf16*)(a.ws + WS_CST);
    for (int e = obid() * 512 + otid(); e < 4 * 16 * 64 * 32; e += gridDim.x * 512) {
        const int b = e >> 15, h = (e >> 11) & 15, pn = e & 2047;
        u32x2* ptr = (u32x2*)(CST + ((size_t)(b * 32 * 16 + h)) * 8192 + (size_t)pn * 4);
        u32x2 v[32]; float dec[32];
#pragma unroll
        for (int c = 0; c < 32; ++c) v[c] = *(ptr + (size_t)c * 16 * 8192 / 4);
#pragma unroll
        for (int c = 0; c < 32; ++c) dec[c] = CS[((size_t)b * SEQ + c * 64 + 63) * 16 + h];
        float st0 = 0.f, st1 = 0.f, st2 = 0.f, st3 = 0.f;
#pragma unroll
        for (int c = 0; c < 32; ++c) {
            const float d = __expf(dec[c]);
            u32x2 o; o.x = pk2(st0, st1); o.y = pk2(st2, st3);
            *(ptr + (size_t)c * 16 * 8192 / 4) = o;
            st0 = fmaf(st0, d, __uint_as_float(v[c].x << 16)); st1 = fmaf(st1, d, __uint_as_float(v[c].x & 0xffff0000u));
            st2 = fmaf(st2, d, __uint_as_float(v[c].y << 16)); st3 = fmaf(st3, d, __uint_as_float(v[c].y & 0xffff0000u));
        }
    }
}

__device__ __forceinline__ void phase_ssd3(const Args& a, int l, float* smem) {
    const bf16* proj = (const bf16*)(a.ws + WS_PROJ);
    const bf16* XC = (const bf16*)(a.ws + WS_XC); const bf16* XT1 = (const bf16*)(a.ws + WS_XT1); const bf16* PREV = (const bf16*)(a.ws + WS_CST);
    const float* DTS = (const float*)(a.ws + WS_DTS); const float* CS = (const float*)(a.ws + WS_CS);
    float* SSQ = (float*)(a.ws + WS_SSQ); bf16* mix = (bf16*)(a.ws + WS_MIX);
    const int tid = otid(), wave = tid >> 6, lane = tid & 63, r = lane & 31, hh = lane >> 5;
    float* ybuf = smem + wave * 4480;
    float* csl = ybuf + 64 * 68; float* dtl = csl + 64;
    for (int u = obid() * 8 + wave; u < 2048; u += gridDim.x * 8) {
        const int b = u >> 9, c = (u >> 4) & 31, h = u & 15, g = h >> 2;
        const size_t row0 = (size_t)b * SEQ + c * 64;
        csl[lane] = CS[(row0 + lane) * 16 + h]; dtl[lane] = DTS[(row0 + lane) * 16 + h];
        asm volatile("s_waitcnt lgkmcnt(0)" ::: "memory");
        const float Dh = a.in[17][l * 16 + h];
        const bf16* prevb = PREV + ((size_t)((b * 32 + c) * 16 + h)) * 64 * 128;
#pragma unroll 1
        for (int lb = 0; lb < 2; ++lb) {
            bf16x8 cf[8];
#pragma unroll
            for (int kk = 0; kk < 8; ++kk) cf[kk] = ld16(XC + (row0 + lb * 32 + r) * 2048 + 1536 + g * 128 + kk * 16 + 8 * hh);
            f32x16 yo[2]; yo[0] = zero16(); yo[1] = zero16();
#pragma unroll
            for (int pb = 0; pb < 2; ++pb)
#pragma unroll
                for (int kk = 0; kk < 8; ++kk) { const bf16x8 pf = ld16(prevb + (pb * 32 + r) * 128 + kk * 16 + 8 * hh); yo[pb] = MFMA32(pf, cf[kk], yo[pb]); }
            const float csL = csl[lb * 32 + r];
            const float eL = __expf(csL);
            f32x16 yd[2]; yd[0] = zero16(); yd[1] = zero16();
#pragma unroll 1
            for (int sb = 0; sb <= lb; ++sb) {
                f32x16 gt = zero16();
#pragma unroll
                for (int kk = 0; kk < 8; ++kk) { const bf16x8 bfm = ld16(XC + (row0 + sb * 32 + r) * 2048 + 1024 + g * 128 + kk * 16 + 8 * hh); gt = MFMA32(bfm, cf[kk], gt); }
                const int lcol = lb * 32 + r;
#pragma unroll
                for (int rg = 0; rg < 16; ++rg) { const int sidx = sb * 32 + crow(rg, hh); const float v = gt[rg] * __expf(fminf(csL - csl[sidx], 0.f)) * dtl[sidx]; gt[rg] = (sidx <= lcol) ? v : 0.f; }
#pragma unroll
                for (int s16 = 0; s16 < 2; ++s16) {
                    u32x4 sv; sv.x = pk2(gt[8 * s16 + 0], gt[8 * s16 + 1]); sv.y = pk2(gt[8 * s16 + 2], gt[8 * s16 + 3]); sv.z = pk2(gt[8 * s16 + 4], gt[8 * s16 + 5]); sv.w = pk2(gt[8 * s16 + 6], gt[8 * s16 + 7]);
                    const bf16x8 sf = __builtin_bit_cast(bf16x8, sv);
#pragma unroll
                    for (int pb = 0; pb < 2; ++pb) {
                        const bf16* xp = XT1 + ((size_t)b * 1024 + h * 64 + pb * 32 + r) * 2048 + c * 64 + sb * 32 + 16 * s16 + 4 * hh;
                        const bf16x8 xf = ld8x2(xp, xp + 8);
                        yd[pb] = MFMA32(xf, sf, yd[pb]);
                    }
                }
            }
#pragma unroll
            for (int pb = 0; pb < 2; ++pb)
#pragma unroll
                for (int rg = 0; rg < 16; ++rg) ybuf[(lb * 32 + r) * 68 + pb * 32 + crow(rg, hh)] = yd[pb][rg] + eL * yo[pb][rg];
        }
        asm volatile("s_waitcnt lgkmcnt(0)" ::: "memory");
#pragma unroll 1
        for (int it = 0; it < 8; ++it) {
            const int lrow = it * 8 + (lane >> 3), p8 = (lane & 7) * 8;
            const size_t row = row0 + lrow;
            const float4 y0 = *(const float4*)(ybuf + lrow * 68 + p8), y1 = *(const float4*)(ybuf + lrow * 68 + p8 + 4);
            float x8[8], z8[8];
            unpack8(*(const u32x4*)(XC + row * 2048 + h * 64 + p8), x8);
            unpack8(*(const u32x4*)(proj + row * PP + P_SSDZ + h * 64 + p8), z8);
            const float yy[8] = {y0.x, y0.y, y0.z, y0.w, y1.x, y1.y, y1.z, y1.w};
            float o[8]; float ss = 0.f;
#pragma unroll
            for (int j = 0; j < 8; ++j) { o[j] = (yy[j] + Dh * x8[j]) * siluf(z8[j]); ss = fmaf(o[j], o[j], ss); }
            ss += __shfl_xor(ss, 1); ss += __shfl_xor(ss, 2); ss += __shfl_xor(ss, 4);
            if ((lane & 7) == 0) SSQ[row * 16 + h] = ss;
            u32x4 w; w.x = pk2(o[0], o[1]); w.y = pk2(o[2], o[3]); w.z = pk2(o[4], o[5]); w.w = pk2(o[6], o[7]);
            *(u32x4*)(mix + row * D_MODEL + MX_SSD + h * 64 + p8) = w;
        }
        asm volatile("s_waitcnt lgkmcnt(0)" ::: "memory");
    }
}

__device__ __forceinline__ void phase_ssd_norm(const Args& a, int l) {
    const float* SSQ = (const float*)(a.ws + WS_SSQ);
    bf16* mix = (bf16*)(a.ws + WS_MIX);
    const float* nwp = a.in[18] + (size_t)l * 1024;
    const int tid = otid(), wave = tid >> 6, lane = tid & 63;
    for (int row = obid() * 8 + wave; row < M_TOK; row += gridDim.x * 8) {
        float s = (lane < 16) ? SSQ[(size_t)row * 16 + lane] : 0.f;
        s = wave_sum(s);
        const float rs = 1.0f / sqrtf(s * (1.0f / 1024.f) + EPS);
#pragma unroll
        for (int j = 0; j < 2; ++j) {
            bf16* p = mix + (size_t)row * D_MODEL + MX_SSD + (lane + 64 * j) * 8;
            float v[8]; unpack8(*(const u32x4*)p, v);
            const float4 w0 = *(const float4*)(nwp + (lane + 64 * j) * 8), w1 = *(const float4*)(nwp + (lane + 64 * j) * 8 + 4);
            u32x4 o; o.x = pk2(v[0] * rs * w0.x, v[1] * rs * w0.y); o.y = pk2(v[2] * rs * w0.z, v[3] * rs * w0.w); o.z = pk2(v[4] * rs * w1.x, v[5] * rs * w1.y); o.w = pk2(v[6] * rs * w1.z, v[7] * rs * w1.w);
            *(u32x4*)p = o;
        }
    }
}

__device__ __forceinline__ int t5_bucket(int rel) {
    const int ret = rel > 0 ? 16 : 0; const int n = rel < 0 ? -rel : rel;
    if (n < 8) return ret + n;
    const int e = 31 - __clz(n);
    int v = 8 + 2 * (e - 3) + ((n * n) >= (1 << (2 * e + 1)) ? 1 : 0);
    return ret + (v < 15 ? v : 15);
}

__device__ __forceinline__ void phase_btab(const Args& a) {
    float* bt = (float*)(a.ws + WS_BTAB);
    for (int i = obid() * 512 + otid(); i < 8 * 4096; i += gridDim.x * 512) { const int h = i >> 12, rel = (i & 4095) - 2048; bt[i] = a.in[19][t5_bucket(rel) * 8 + h] * 1.4426950408889634f; }
}

typedef float f32x4v __attribute__((ext_vector_type(4)));
constexpr int SC_STRIDE = 2052;
__device__ __forceinline__ unsigned cvtpk(float lo, float hi) { unsigned r; asm("v_cvt_pk_bf16_f32 %0, %1, %2" : "=v"(r) : "v"(lo), "v"(hi)); return r; }
__device__ __forceinline__ float rows_max(float x) {
    auto r = __builtin_amdgcn_permlane32_swap(__float_as_uint(x), __float_as_uint(x), false, false); x = fmaxf(__uint_as_float(r[0]), __uint_as_float(r[1]));
    auto q = __builtin_amdgcn_permlane16_swap(__float_as_uint(x), __float_as_uint(x), false, false); return fmaxf(__uint_as_float(q[0]), __uint_as_float(q[1]));
}
__device__ __forceinline__ float rows_sum(float x) {
    auto r = __builtin_amdgcn_permlane32_swap(__float_as_uint(x), __float_as_uint(x), false, false); x = __uint_as_float(r[0]) + __uint_as_float(r[1]);
    auto q = __builtin_amdgcn_permlane16_swap(__float_as_uint(x), __float_as_uint(x), false, false); return __uint_as_float(q[0]) + __uint_as_float(q[1]);
}
__device__ __forceinline__ int wave_isum(int x) {
    x += __builtin_amdgcn_update_dpp(0, x, 0x111, 0xf, 0xf, true);
    x += __builtin_amdgcn_update_dpp(0, x, 0x112, 0xf, 0xf, true);
    x += __builtin_amdgcn_update_dpp(0, x, 0x114, 0xf, 0xf, true);
    x += __builtin_amdgcn_update_dpp(0, x, 0x118, 0xf, 0xf, true);
    x += __builtin_amdgcn_update_dpp(0, x, 0x142, 0xa, 0xf, false);
    x += __builtin_amdgcn_update_dpp(0, x, 0x143, 0xc, 0xf, false);
    return __builtin_amdgcn_readlane(x, 63);
}
__device__ __forceinline__ unsigned wave_umin(unsigned v) {
#pragma unroll
    for (int o = 1; o < 64; o <<= 1) { const unsigned t = (unsigned)__shfl_xor((int)v, o); v = t < v ? t : v; }
    return v;
}
__device__ __forceinline__ unsigned wave_umax(unsigned v) {
#pragma unroll
    for (int o = 1; o < 64; o <<= 1) { const unsigned t = (unsigned)__shfl_xor((int)v, o); v = t > v ? t : v; }
    return v;
}
template <int NW>
__device__ __forceinline__ void dsa_select2(const float* sc, unsigned long long* msk, int q0, int c, int lane) {
    unsigned ka[NW], kb[NW];
    unsigned mna = 0xffffffffu, mxa = 0u, mnb = 0xffffffffu, mxb = 0u;
#pragma unroll
    for (int r = 0; r < NW; ++r) {
        ka[r] = 0u; kb[r] = 0u;
        if (r <= c) {
            const unsigned ua = __float_as_uint(sc[q0 * SC_STRIDE + r * 64 + lane]), ub = __float_as_uint(sc[(q0 + 1) * SC_STRIDE + r * 64 + lane]);
            ka[r] = (ua & 0x80000000u) ? ~ua : (ua | 0x80000000u); kb[r] = (ub & 0x80000000u) ? ~ub : (ub | 0x80000000u);
            mna = ka[r] < mna ? ka[r] : mna; mxa = ka[r] > mxa ? ka[r] : mxa; mnb = kb[r] < mnb ? kb[r] : mnb; mxb = kb[r] > mxb ? kb[r] : mxb;
        }
    }
    unsigned loa = __builtin_amdgcn_readfirstlane(wave_umin(mna)), hia = __builtin_amdgcn_readfirstlane(wave_umax(mxa));
    unsigned lob = __builtin_amdgcn_readfirstlane(wave_umin(mnb)), hib = __builtin_amdgcn_readfirstlane(wave_umax(mxb));
    bool fa = (loa == hia), fb = (lob == hib), exa = false, exb = false;
    unsigned Ta = loa, Tb = lob;
    while (!(fa && fb)) {
        const unsigned da = hia - loa, db = hib - lob;
        const unsigned mida = loa + (da >> 1) + (da & 1u), midb = lob + (db >> 1) + (db & 1u);
        int cnt = 0;
#pragma unroll
        for (int r = 0; r < NW; ++r) { cnt += (ka[r] >= mida) ? 1 : 0; cnt += (kb[r] >= midb) ? 65536 : 0; }
        const int tot = wave_isum(cnt);
        const int ta = tot & 0xffff, tb = tot >> 16;
        if (!fa) { if (ta >= 256) loa = mida; else hia = mida - 1u; if (ta == 256) { fa = true; exa = true; Ta = mida; } else if (loa == hia) { fa = true; Ta = loa; } }
        if (!fb) { if (tb >= 256) lob = midb; else hib = midb - 1u; if (tb == 256) { fb = true; exb = true; Tb = midb; } else if (lob == hib) { fb = true; Tb = lob; } }
    }
#pragma unroll
    for (int qq = 0; qq < 2; ++qq) {
        const unsigned T = qq ? Tb : Ta; const bool ex = qq ? exb : exa;
        unsigned long long* mq = msk + (q0 + qq) * 32;
        if (ex) {
#pragma unroll
            for (int r = 0; r < NW; ++r) if (r <= c) { const unsigned long long m = __ballot((qq ? kb[r] : ka[r]) >= T); if (lane == 0) mq[r] = m; }
        } else {
            int cgt = 0;
#pragma unroll
            for (int r = 0; r < NW; ++r) cgt += ((qq ? kb[r] : ka[r]) > T) ? 1 : 0;
            int need = 256 - wave_isum(cgt);
#pragma unroll
            for (int r = 0; r < NW; ++r) if (r <= c) {
                const unsigned kv = qq ? kb[r] : ka[r];
                const unsigned long long gm = __ballot(kv > T); unsigned long long em = __ballot(kv == T);
                const int pc = __popcll(em);
                if (pc <= need) need -= pc;
                else { while (__popcll(em) > need) em &= ~(1ull << (63 - __clzll((long long)em))); need = 0; }
                if (lane == 0) mq[r] = gm | em;
            }
        }
    }
}
__device__ __forceinline__ void dsa_unit(const Args& a, int unit, float* smem) {
    const bf16* proj = (const bf16*)(a.ws + WS_PROJ);
    const float* side = (const float*)(a.ws + WS_SIDE);
    const bf16* VF = (const bf16*)(a.ws + WS_VF); const bf16* KF = (const bf16*)(a.ws + WS_KF); const bf16* IKF = (const bf16*)(a.ws + WS_IKF);
    const float* BT = (const float*)(a.ws + WS_BTAB);
    bf16* mix = (bf16*)(a.ws + WS_MIX);
    float* sc = smem;
    unsigned long long* msk = (unsigned long long*)(smem + 16 * SC_STRIDE);
    const int tid = otid(), wave = tid >> 6, lane = tid & 63, cc = lane & 15, q4 = lane >> 4;
    const int b = unit >> 7, q16 = unit & 127, c = q16 >> 2, nk = 64 * (c + 1);
    const int tq0 = q16 * 16;
    const size_t rowb = (size_t)b * SEQ, rowq = rowb + tq0;
    __syncthreads();
    {
        bf16x8 aq[8][2]; float wq[4][8];
#pragma unroll
        for (int h = 0; h < 8; ++h)
#pragma unroll
            for (int kk = 0; kk < 2; ++kk) aq[h][kk] = ld16(proj + (rowq + cc) * PP + P_IQ + h * 64 + kk * 32 + 8 * q4);
#pragma unroll
        for (int rg = 0; rg < 4; ++rg) {
            const float4 w0 = *(const float4*)(side + (rowq + q4 * 4 + rg) * 32 + 16), w1 = *(const float4*)(side + (rowq + q4 * 4 + rg) * 32 + 20);
            const float sc_ = 0.044194173824159216f;
            wq[rg][0] = w0.x * sc_; wq[rg][1] = w0.y * sc_; wq[rg][2] = w0.z * sc_; wq[rg][3] = w0.w * sc_; wq[rg][4] = w1.x * sc_; wq[rg][5] = w1.y * sc_; wq[rg][6] = w1.z * sc_; wq[rg][7] = w1.w * sc_;
        }
        const int nkb = 4 * (c + 1);
        const bf16* ikb = IKF + (size_t)b * 128 * 2 * 512 + lane * 8;
        bf16x8 nb0 = ld16(ikb + (size_t)wave * 1024), nb1 = ld16(ikb + (size_t)wave * 1024 + 512);
#pragma unroll 1
        for (int kb = wave; kb < nkb; kb += 8) {
            const int key0 = kb * 16;
            const bf16x8 bk0 = nb0, bk1 = nb1;
            { const int kn = (kb + 8 < nkb) ? kb + 8 : kb; nb0 = ld16(ikb + (size_t)kn * 1024); nb1 = ld16(ikb + (size_t)kn * 1024 + 512); }
            f32x4v s4 = {0.f, 0.f, 0.f, 0.f};
#pragma unroll
            for (int h = 0; h < 8; ++h) {
                f32x4v acc = {0.f, 0.f, 0.f, 0.f};
                acc = MFMA16(aq[h][0], bk0, acc); acc = MFMA16(aq[h][1], bk1, acc);
#pragma unroll
                for (int rg = 0; rg < 4; ++rg) s4[rg] = fmaf(fmaxf(acc[rg], 0.f), wq[rg][h], s4[rg]);
            }
#pragma unroll
            for (int rg = 0; rg < 4; ++rg) sc[(q4 * 4 + rg) * SC_STRIDE + key0 + cc] = s4[rg] + 0.0f;
        }
    }
    __syncthreads();
    if (nk <= 256) {
        if (lane <= c) { msk[(wave * 2) * 32 + lane] = ~0ull; msk[(wave * 2 + 1) * 32 + lane] = ~0ull; }
    } else if (c < 8) dsa_select2<8>(sc, msk, wave * 2, c, lane);
    else if (c < 16) dsa_select2<16>(sc, msk, wave * 2, c, lane);
    else if (c < 24) dsa_select2<24>(sc, msk, wave * 2, c, lane);
    else dsa_select2<32>(sc, msk, wave * 2, c, lane);
    __syncthreads();
    {
        const int h = wave;
        const bf16x8 bq0 = ld16(proj + (rowq + cc) * PP + P_AQ + h * 64 + 8 * q4), bq1 = ld16(proj + (rowq + cc) * PP + P_AQ + h * 64 + 32 + 8 * q4);
        f32x4v o[4];
#pragma unroll
        for (int dt = 0; dt < 4; ++dt) o[dt] = (f32x4v){0.f, 0.f, 0.f, 0.f};
        float m = -INFINITY, lsum = 0.f;
        const float* bbp = BT + h * 4096 + 2048 - (tq0 + cc) + q4 * 4;
        const int nst = 2 * (c + 1);
        const bf16* kfb = KF + (size_t)b * 64 * 2048 + lane * 8;
        const bf16* vfb = VF + (size_t)b * 64 * 2048 + lane * 8;
        const unsigned long long* mrow = msk + cc * 32;
        struct CSet { bf16x8 k00, k01, k10, k11, v0, v1, v2, v3; float4 ba, bb; };
#define DSA_LOAD(S, ks_) do { const bf16* kp_ = kfb + (size_t)(ks_) * 2048; const bf16* vp_ = vfb + (size_t)(ks_) * 2048; \
        S.k00 = ld16(kp_); S.k01 = ld16(kp_ + 512); S.k10 = ld16(kp_ + 1024); S.k11 = ld16(kp_ + 1536); \
        S.v0 = ld16(vp_); S.v1 = ld16(vp_ + 512); S.v2 = ld16(vp_ + 1024); S.v3 = ld16(vp_ + 1536); \
        S.ba = *(const float4*)(bbp + (ks_) * 32); S.bb = *(const float4*)(bbp + (ks_) * 32 + 16); asm volatile("" ::: "memory"); } while (0)
#define DSA_STEP(S, ks_) do { const int kbase_ = (ks_) * 32; \
        f32x4v s0 = {0.f, 0.f, 0.f, 0.f}, s1 = {0.f, 0.f, 0.f, 0.f}; \
        s0 = MFMA16(S.k00, bq0, s0); s0 = MFMA16(S.k01, bq1, s0); s1 = MFMA16(S.k10, bq0, s1); s1 = MFMA16(S.k11, bq1, s1); \
        const unsigned long long mw_ = mrow[kbase_ >> 6]; const unsigned bits_ = (unsigned)(mw_ >> ((kbase_ & 63) + q4 * 4)); \
        const float bia_[8] = {S.ba.x, S.ba.y, S.ba.z, S.ba.w, S.bb.x, S.bb.y, S.bb.z, S.bb.w}; \
        float lg_[8]; float mx_ = -INFINITY; \
        _Pragma("unroll") for (int rg = 0; rg < 4; ++rg) { \
            lg_[rg] = ((bits_ >> rg) & 1u) ? fmaf(s0[rg], 0.18033688011112042f, bia_[rg]) : -INFINITY; \
            lg_[4 + rg] = ((bits_ >> (16 + rg)) & 1u) ? fmaf(s1[rg], 0.18033688011112042f, bia_[4 + rg]) : -INFINITY; \
            mx_ = fmaxf(mx_, fmaxf(lg_[rg], lg_[4 + rg])); } \
        mx_ = rows_max(mx_); \
        if (__any(mx_ > m)) { const float mn_ = fmaxf(m, mx_); const float al_ = (mn_ == -INFINITY) ? 1.f : __builtin_amdgcn_exp2f(m - mn_); m = mn_; lsum *= al_; \
            _Pragma("unroll") for (int dt = 0; dt < 4; ++dt) o[dt] = o[dt] * al_; } \
        const float msub_ = (m == -INFINITY) ? 0.f : m; \
        float p_[8]; float ps_ = 0.f; \
        _Pragma("unroll") for (int jj = 0; jj < 8; ++jj) { p_[jj] = __builtin_amdgcn_exp2f(lg_[jj] - msub_); ps_ += p_[jj]; } \
        lsum += ps_; \
        u32x4 pv_; pv_.x = cvtpk(p_[0], p_[1]); pv_.y = cvtpk(p_[2], p_[3]); pv_.z = cvtpk(p_[4], p_[5]); pv_.w = cvtpk(p_[6], p_[7]); \
        const bf16x8 pf_ = __builtin_bit_cast(bf16x8, pv_); \
        o[0] = MFMA16(S.v0, pf_, o[0]); o[1] = MFMA16(S.v1, pf_, o[1]); o[2] = MFMA16(S.v2, pf_, o[2]); o[3] = MFMA16(S.v3, pf_, o[3]); } while (0)
        CSet SA, SB;
        DSA_LOAD(SA, 0);
#pragma unroll 1
        for (int ks = 0; ks < nst; ks += 2) {
            DSA_LOAD(SB, ks + 1);
            DSA_STEP(SA, ks);
            { const int kn = (ks + 2 < nst) ? ks + 2 : ks; DSA_LOAD(SA, kn); }
            DSA_STEP(SB, ks + 1);
        }
#undef DSA_LOAD
#undef DSA_STEP
        lsum = rows_sum(lsum);
        const float inv = 1.0f / lsum;
#pragma unroll
        for (int dt = 0; dt < 4; ++dt) {
            const int d0 = dt * 16 + q4 * 4;
            const float4 z = ldbf4(proj + (rowq + cc) * PP + P_AZ + h * 64 + d0);
            u32x2 w; w.x = pk2(o[dt][0] * inv * siluf(z.x), o[dt][1] * inv * siluf(z.y)); w.y = pk2(o[dt][2] * inv * siluf(z.z), o[dt][3] * inv * siluf(z.w));
            *(u32x2*)(mix + (rowq + cc) * D_MODEL + MX_ATT + h * 64 + d0) = w;
        }
    }
}
__device__ __forceinline__ void phase_dsa(const Args& a, int l, float* smem) {
    unsigned* ctr = (unsigned*)(a.ws + WS_CTL) + 15360 + 64 * l;
    volatile int* slot = (volatile int*)(smem + (147456 - 192) / 4);
    for (;;) {
        __syncthreads();
        if (otid() == 0) *slot = (int)__hip_atomic_fetch_add(ctr, 1u, __ATOMIC_RELAXED, __HIP_MEMORY_SCOPE_AGENT);
        __syncthreads();
        const int u = *slot;
        if (u >= 512) break;
        const int c = 31 - (u >> 4), r = u & 15;
        dsa_unit(a, (r >> 2) * 128 + c * 4 + (r & 3), smem);
    }
}

#define XB_TMO      128
#define XB_XCNT(j)  (256  + 64 * (j))
#define XB_XSUB(j)  (1280 + 64 * (j))
#define XB_XGEN(j)  (2304 + 64 * (j))
#define XB_TOP      3328
#define XB_TOPGEN   3392
#define XCD_BAR_WORDS 3456
#define XB_SPIN_CAP (1u << 18)

__device__ __forceinline__ unsigned xb_ld(unsigned* p)              { return __hip_atomic_load(p, __ATOMIC_RELAXED, __HIP_MEMORY_SCOPE_AGENT); }
__device__ __forceinline__ unsigned xb_add(unsigned* p, unsigned v) { return __hip_atomic_fetch_add(p, v, __ATOMIC_RELAXED, __HIP_MEMORY_SCOPE_AGENT); }
__device__ __forceinline__ unsigned xb_xcc_id() { return (unsigned)__builtin_amdgcn_s_getreg((3 << 11) | 20) & 0xFu; }
#define XB_SPIN(cond, bar) do { unsigned _sp = 0; while (cond) { __builtin_amdgcn_s_sleep(1); \
    if ((++_sp & 255u) == 0u) { if (xb_ld(&(bar)[XB_TMO])) break; if (_sp > XB_SPIN_CAP) { atomicAdd(&(bar)[XB_TMO], 1u); break; } } } } while (0)

struct XcdBarrier {
    unsigned* bar; unsigned x;
    volatile LAS unsigned* st;
};

__device__ __forceinline__ XcdBarrier xcd_barrier_post(unsigned* bar, volatile LAS unsigned* st) {
    XcdBarrier b; b.bar = bar; b.x = xb_xcc_id(); b.st = st;
    if (threadIdx.x == 0) (void)xb_add(&bar[XB_XCNT(b.x)], 1u);
    return b;
}
__device__ __forceinline__ void xcd_barrier_complete(unsigned* bar, unsigned x, unsigned& nloc, unsigned& nx) {
    const unsigned G = gridDim.x * gridDim.y * gridDim.z;
    unsigned sum, cnt, mine, sp = 0u;
    for (;;) {
        sum = 0u; cnt = 0u; mine = 0u;
#pragma unroll
        for (unsigned j = 0; j < 16; ++j) { const unsigned c = xb_ld(&bar[XB_XCNT(j)]); sum += c; cnt += (c > 0u) ? 1u : 0u; mine = (j == x) ? c : mine; }
        if (sum == G) break;
        __builtin_amdgcn_s_sleep(1);
        if ((++sp & 255u) == 0u) { if (xb_ld(&bar[XB_TMO])) break; if (sp > XB_SPIN_CAP) { atomicAdd(&bar[XB_TMO], 1u); break; } }
    }
    nloc = mine > 0u ? mine : 1u; nx = cnt > 0u ? cnt : 1u;
}

__device__ __forceinline__ void xcd_barrier(const XcdBarrier& b) {
    asm volatile("s_waitcnt vmcnt(0)" ::: "memory");
    __syncthreads();
    if (threadIdx.x == 0) {
        unsigned* bar = b.bar;
        __builtin_amdgcn_s_waitcnt(0);
        unsigned nloc = b.st[0], nx = b.st[1];
        if (nloc == 0u) { xcd_barrier_complete(bar, b.x, nloc, nx); b.st[0] = nloc; b.st[1] = nx; }
        const unsigned old = xb_add(&bar[XB_XSUB(b.x)], 1u);
        const unsigned gen = old / nloc;
        if (old + 1u == (gen + 1u) * nloc) {
            __builtin_amdgcn_fence(__ATOMIC_RELEASE, "agent");
            asm volatile("s_waitcnt vmcnt(0)" ::: "memory");
            const unsigned og = xb_add(&bar[XB_TOP], 1u);
            const unsigned tg = og / nx;
            if (og + 1u == (tg + 1u) * nx) xb_add(&bar[XB_TOPGEN], 1u);
            else XB_SPIN(xb_ld(&bar[XB_TOPGEN]) == tg, bar);
            __builtin_amdgcn_fence(__ATOMIC_ACQUIRE, "agent");
            xb_add(&bar[XB_XGEN(b.x)], 1u);
            asm volatile("s_waitcnt vmcnt(0)" ::: "memory");
        } else {
            XB_SPIN(xb_ld(&bar[XB_XGEN(b.x)]) == gen, bar);
            __builtin_amdgcn_fence(__ATOMIC_ACQUIRE, "agent");
            asm volatile("s_waitcnt vmcnt(0)" ::: "memory");
        }
    }
    __syncthreads();
}


constexpr int LDS_BYTES = 147456;
__global__ void __launch_bounds__(512, 2) mk_fwd(Args a) {
    extern __shared__ __attribute__((aligned(16))) unsigned char lds[];
    float* smem = (float*)lds;
    cg::grid_group grid = cg::this_grid();
    const int G = gridDim.x;
    volatile LAS unsigned* MISC = (volatile LAS unsigned*)((LAS unsigned char*)lds + (LDS_BYTES - 256));
    if (threadIdx.x < 64) MISC[threadIdx.x] = 0u;
    __syncthreads();
    XcdBarrier bar = xcd_barrier_post((unsigned*)(a.ws + WS_CTL) + 4096, MISC + 8);
    bf16* XB = (bf16*)(a.ws + WS_XB); bf16* PROJ = (bf16*)(a.ws + WS_PROJ); bf16* MIX = (bf16*)(a.ws + WS_MIX); bf16* YG = (bf16*)(a.ws + WS_YG);
    phase_prologue(a, smem);
    phase_btab(a);
    grid.sync();
    for (int l = 0; l < DEPTH; ++l) {
        const float* xcur = (l == 0) ? a.in[0] : a.out;
        {
            pg8::Gemm g{XB, (const bf16*)(a.ws + WS_WIN + l * WIN_L), M_TOK, PP, D_MODEL}; pg8::StaticOrder S; S.init(M_TOK, PP, G, obid());
            EpiProj E{PROJ, (float*)(a.ws + WS_SIDE), (bf16*)(a.ws + WS_VF), (bf16*)(a.ws + WS_KF), (bf16*)(a.ws + WS_IKF), (const float*)(a.ws + WS_SSQX)};
            pg8::gemm_phase<EpiProj, pg8::StaticOrder, true, true>((LAS unsigned char*)lds, g, S, E);
        }
        xcd_barrier(bar);
        phase_s5(a, l, smem);
        phase_ssd_pre(a, l, smem);
        phase_dsa(a, l, smem);
        xcd_barrier(bar);
        {
            pg8::Gemm g{YG, (const bf16*)(a.ws + WS_WGLU + l * WGLU_L), M_TOK, 512, 512}; pg8::StaticOrder S; S.init(M_TOK, 512, G, obid());
            EpiGlu E{YG, PROJ, a.in[12] + (size_t)l * 512, MIX};
            pg8::gemm_phase<EpiGlu, pg8::StaticOrder, true, true>((LAS unsigned char*)lds, g, S, E);
        }
        phase_ssd1(a);
        xcd_barrier(bar);
        phase_ssd2(a);
        xcd_barrier(bar);
        phase_ssd3(a, l, smem);
        xcd_barrier(bar);
        phase_ssd_norm(a, l);
        xcd_barrier(bar);
        {
            pg8::Gemm g{MIX, (const bf16*)(a.ws + WS_WOUT + l * WOUT_L), M_TOK, D_MODEL, D_MODEL}; pg8::StaticOrder S; S.init(M_TOK, D_MODEL, G, obid());
            EpiOutNorm E{xcur, a.out, XB, (float*)(a.ws + WS_SSQX)};
            pg8::gemm_phase<EpiOutNorm, pg8::StaticOrder, false, true>((LAS unsigned char*)lds, g, S, E);
        }
        xcd_barrier(bar);
    }
    phase_final_norm(a.out, a.in[21], (const float*)(a.ws + WS_SSQX));
}

extern "C" void kernel_launch(void* const* d_in, const int* in_sizes, int n_in, void* d_out, int out_size, void* d_ws, size_t ws_size, hipStream_t stream) {
    if (n_in != 22 || out_size != M_TOK * D_MODEL || ws_size < WS_END) {
        fprintf(stderr, "kernel_launch: unexpected problem: n_in %d out %d ws %zu\n", n_in, out_size, ws_size);
        return;
    }
    static int grid_blocks = 0;
    if (!grid_blocks) {
        int dev = 0, cus = 0, per_cu = 0;
        (void)hipGetDevice(&dev);
        (void)hipDeviceGetAttribute(&cus, hipDeviceAttributeMultiprocessorCount, dev);
        (void)hipFuncSetAttribute((const void*)mk_fwd, hipFuncAttributeMaxDynamicSharedMemorySize, LDS_BYTES);
        (void)hipOccupancyMaxActiveBlocksPerMultiprocessor(&per_cu, (const void*)mk_fwd, 512, LDS_BYTES);
        if (per_cu < 1) fprintf(stderr, "kernel_launch: occupancy query says %d blocks/CU\n", per_cu);
        grid_blocks = cus;
    }
    Args a{};
    for (int i = 0; i < 22; ++i) a.in[i] = (const float*)d_in[i];
    a.out = (float*)d_out; a.ws = (unsigned char*)d_ws;
    (void)hipMemsetAsync((char*)d_ws + WS_CTL, 0, 65536, stream);
    void* args[] = {&a};
    hipError_t e = hipLaunchCooperativeKernel((void*)mk_fwd, dim3(grid_blocks), dim3(512), args, LDS_BYTES, stream);
    if (e != hipSuccess) fprintf(stderr, "cooperative launch failed: %s (grid %d)\n", hipGetErrorString(e), grid_blocks);
}
```
